# Optimizing an MI355X kernel written in HIP

```python
import jax, jax.numpy as jnp
from jax import lax
import numpy as np

D_MODEL = 1024
BATCH = 2
SEQ = 16384
DEPTH = 4

GRID_W = 64
Q_BLOCK = 128
ROPE_THETA = 10000.0
EPS = 1e-6
D_FF = 2816
GQA_HEADS = 8
GQA_KV_HEADS = 2
GQA_HEAD_DIM = 64
SC_WIDTH = 512
SC_KERNEL = 3
MLA_HEADS = 8
MLA_Q_LORA = 384
MLA_KV_LORA = 256
MLA_NOPE = 64
MLA_ROPE = 32
MLA_V = 64
LRU_WIDTH = 512
LRU_BLOCKS = 8
LRU_BLOCK_W = LRU_WIDTH // LRU_BLOCKS
LRU_CONV = 4
LRU_C = 8.0
N_BRANCH = 4
BRANCH_W = 512
IN_SIZES = (
    GQA_HEADS * GQA_HEAD_DIM,
    GQA_KV_HEADS * GQA_HEAD_DIM,
    GQA_KV_HEADS * GQA_HEAD_DIM,
    3 * SC_WIDTH,
    MLA_Q_LORA,
    MLA_KV_LORA,
    MLA_ROPE,
    2 * LRU_WIDTH,
    N_BRANCH * D_MODEL,
)
IN_TOTAL = sum(IN_SIZES)

kernel_name = "hybrid_gqa_shortconv_mla_rglru_macaron_encoder"


def rmsnorm(x, g):
    xf = x.astype(jnp.float32)
    y = xf * lax.rsqrt(jnp.mean(xf * xf, axis=-1, keepdims=True) + EPS)
    return (y * g.astype(jnp.float32)).astype(x.dtype)


def swiglu_ffn(x, g, wi, wo):
    gate, up = jnp.split(rmsnorm(x, g) @ wi, 2, axis=-1)
    return (jax.nn.silu(gate) * up) @ wo


def rope_angles(pos, dim):
    inv = ROPE_THETA ** (-jnp.arange(0, dim, 2, dtype=jnp.float32) / dim)
    return pos[:, None] * inv[None, :]


def apply_rope_1d(x, ang):
    cos = jnp.cos(ang)[None, :, None, :].astype(x.dtype)
    sin = jnp.sin(ang)[None, :, None, :].astype(x.dtype)
    x1, x2 = jnp.split(x, 2, axis=-1)
    return jnp.concatenate([x1 * cos - x2 * sin, x2 * cos + x1 * sin], axis=-1)


def apply_axial_rope(x, ang_row, ang_col):
    half = x.shape[-1] // 2
    return jnp.concatenate([apply_rope_1d(x[..., :half], ang_row),
                            apply_rope_1d(x[..., half:], ang_col)], axis=-1)


def block_attention(q, k, v):
    b, hk, g, s, d = q.shape
    nb = s // Q_BLOCK
    qb = jnp.moveaxis(q.reshape(b, hk, g, nb, Q_BLOCK, d), 3, 0)
    scale = d ** -0.5

    def one_block(qi):
        sc = jnp.einsum('bkgqd,bksd->bkgqs', qi, k).astype(jnp.float32) * scale
        p = jax.nn.softmax(sc, axis=-1).astype(v.dtype)
        return jnp.einsum('bkgqs,bksv->bkgqv', p, v)

    o = lax.map(one_block, qb)
    return jnp.moveaxis(o, 0, 3).reshape(b, hk, g, s, v.shape[-1])


def dwconv(x, w, bias, left):
    width = w.shape[0]
    s = x.shape[1]
    xp = jnp.pad(x, ((0, 0), (left, width - 1 - left), (0, 0)))
    out = bias
    for tap in range(width):
        out = out + w[tap] * xp[:, tap:tap + s]
    return out


def gqa_mixer(q, k, v, qn, kn, ang_r, ang_c):
    b, s, _ = q.shape
    grp = GQA_HEADS // GQA_KV_HEADS
    q = q.reshape(b, s, GQA_HEADS, GQA_HEAD_DIM)
    k = k.reshape(b, s, GQA_KV_HEADS, GQA_HEAD_DIM)
    v = v.reshape(b, s, GQA_KV_HEADS, GQA_HEAD_DIM)
    q = apply_axial_rope(rmsnorm(q, qn), ang_r, ang_c)
    k = apply_axial_rope(rmsnorm(k, kn), ang_r, ang_c)
    qh = q.reshape(b, s, GQA_KV_HEADS, grp, GQA_HEAD_DIM).transpose(0, 2, 3, 1, 4)
    o = block_attention(qh, k.transpose(0, 2, 1, 3), v.transpose(0, 2, 1, 3))
    return o.transpose(0, 3, 1, 2, 4).reshape(b, s, GQA_HEADS * GQA_HEAD_DIM)


def shortconv_mixer(u, w, bias):
    bg, cg, xs = jnp.split(u, 3, axis=-1)
    return bg * dwconv(cg * xs, w, bias, left=SC_KERNEL // 2)


def mla_mixer(q_lat, kv_lat, k_rope, qa_norm, wq_up, kva_norm, wkv_up, qn, kn, ang_r, ang_c):
    b, s, _ = q_lat.shape
    q = (rmsnorm(q_lat, qa_norm) @ wq_up).reshape(b, s, MLA_HEADS, MLA_NOPE + MLA_ROPE)
    kv = (rmsnorm(kv_lat, kva_norm) @ wkv_up).reshape(b, s, MLA_HEADS, MLA_NOPE + MLA_V)
    k_nope, v = kv[..., :MLA_NOPE], kv[..., MLA_NOPE:]
    k_r = jnp.broadcast_to(k_rope[:, :, None, :], (b, s, MLA_HEADS, MLA_ROPE))
    k = jnp.concatenate([k_nope, k_r], axis=-1)
    q = rmsnorm(q, qn)
    k = rmsnorm(k, kn)
    q = jnp.concatenate([q[..., :MLA_NOPE], apply_axial_rope(q[..., MLA_NOPE:], ang_r, ang_c)], axis=-1)
    k = jnp.concatenate([k[..., :MLA_NOPE], apply_axial_rope(k[..., MLA_NOPE:], ang_r, ang_c)], axis=-1)
    qh = q.transpose(0, 2, 1, 3)[:, :, None]
    o = block_attention(qh, k.transpose(0, 2, 1, 3), v.transpose(0, 2, 1, 3))
    return o[:, :, 0].transpose(0, 2, 1, 3).reshape(b, s, MLA_HEADS * MLA_V)


def linear_scan(a, bval):
    def combine(left, right):
        a1, b1 = left
        a2, b2 = right
        return a1 * a2, a2 * b1 + b2
    return lax.associative_scan(combine, (a, bval), axis=1)[1]


def rglru_direction(xc, wa, ba, wx, bx, lam, reverse):
    b, s, w = xc.shape
    xh = xc.reshape(b, s, LRU_BLOCKS, LRU_BLOCK_W)
    r = jax.nn.sigmoid(jnp.einsum('bsnc,ncd->bsnd', xh, wa).reshape(b, s, w) + ba)
    i = jax.nn.sigmoid(jnp.einsum('bsnc,ncd->bsnd', xh, wx).reshape(b, s, w) + bx)
    log_a = -LRU_C * r * jax.nn.softplus(-lam)
    a = jnp.exp(log_a)
    mult = jnp.sqrt(-jnp.expm1(2.0 * log_a))
    bval = mult * (i * xc)
    if reverse:
        return jnp.flip(linear_scan(jnp.flip(a, 1), jnp.flip(bval, 1)), 1)
    return linear_scan(a, bval)


def rglru_mixer(u, conv_w, conv_b, wa, ba, wx, bx, lam):
    gate, xb = jnp.split(u, 2, axis=-1)
    xc = dwconv(xb, conv_w, conv_b, left=LRU_CONV // 2)
    h = (rglru_direction(xc, wa[0], ba[0], wx[0], bx[0], lam[0], False)
         + rglru_direction(xc, wa[1], ba[1], wx[1], bx[1], lam[1], True))
    return jax.nn.gelu(gate) * h


def setup_inputs(seed: int = 0) -> dict:
    key = jax.random.key(seed)
    ks = iter(jax.random.split(key, 32))
    L, D = DEPTH, D_MODEL
    f32 = jnp.float32

    def nrm(shape, fan_in):
        return jax.random.normal(next(ks), shape, f32) * fan_in ** -0.5

    def gain(shape):
        return 1.0 + 0.05 * jax.random.normal(next(ks), shape, f32)

    def bias(shape, scale=0.02):
        return scale * jax.random.normal(next(ks), shape, f32)

    def lru_lambda(shape):
        a0 = jax.random.uniform(next(ks), shape, f32, minval=0.9, maxval=0.999)
        a_base = a0 ** (1.0 / LRU_C)
        return jnp.log(a_base) - jnp.log1p(-a_base)

    return {
        "x": jax.random.normal(next(ks), (BATCH, SEQ, D), f32),
        "ffn1_norm": gain((L, D)),
        "ffn1_wi": nrm((L, D, 2 * D_FF), D),
        "ffn1_wo": nrm((L, D_FF, D), D_FF),
        "mix_norm": gain((L, D)),
        "w_in": nrm((L, D, IN_TOTAL), D),
        "gqa_q_norm": gain((L, GQA_HEAD_DIM)),
        "gqa_k_norm": gain((L, GQA_HEAD_DIM)),
        "sc_conv_w": nrm((L, SC_KERNEL, SC_WIDTH), SC_KERNEL),
        "sc_conv_b": bias((L, SC_WIDTH)),
        "mla_qa_norm": gain((L, MLA_Q_LORA)),
        "mla_wq_up": nrm((L, MLA_Q_LORA, MLA_HEADS * (MLA_NOPE + MLA_ROPE)), MLA_Q_LORA),
        "mla_kva_norm": gain((L, MLA_KV_LORA)),
        "mla_wkv_up": nrm((L, MLA_KV_LORA, MLA_HEADS * (MLA_NOPE + MLA_V)), MLA_KV_LORA),
        "mla_q_norm": gain((L, MLA_NOPE + MLA_ROPE)),
        "mla_k_norm": gain((L, MLA_NOPE + MLA_ROPE)),
        "lru_conv_w": nrm((L, LRU_CONV, LRU_WIDTH), LRU_CONV),
        "lru_conv_b": bias((L, LRU_WIDTH)),
        "lru_wa": nrm((L, 2, LRU_BLOCKS, LRU_BLOCK_W, LRU_BLOCK_W), LRU_BLOCK_W),
        "lru_ba": bias((L, 2, LRU_WIDTH), 0.1),
        "lru_wx": nrm((L, 2, LRU_BLOCKS, LRU_BLOCK_W, LRU_BLOCK_W), LRU_BLOCK_W),
        "lru_bx": bias((L, 2, LRU_WIDTH), 0.1),
        "lru_lambda": lru_lambda((L, 2, LRU_WIDTH)),
        "w_branch": nrm((L, N_BRANCH, BRANCH_W, D), BRANCH_W),
        "w_out": nrm((L, D, D), D),
        "ffn2_norm": gain((L, D)),
        "ffn2_wi": nrm((L, D, 2 * D_FF), D),
        "ffn2_wo": nrm((L, D_FF, D), D_FF),
    }


def reference(x, ffn1_norm, ffn1_wi, ffn1_wo, mix_norm, w_in, gqa_q_norm, gqa_k_norm,
              sc_conv_w, sc_conv_b, mla_qa_norm, mla_wq_up, mla_kva_norm, mla_wkv_up,
              mla_q_norm, mla_k_norm, lru_conv_w, lru_conv_b, lru_wa, lru_ba, lru_wx,
              lru_bx, lru_lambda, w_branch, w_out, ffn2_norm, ffn2_wi, ffn2_wo):
    b, s, d = x.shape
    rows = s // GRID_W
    row_pos = jnp.repeat(jnp.arange(rows, dtype=jnp.float32), GRID_W)
    col_pos = jnp.tile(jnp.arange(GRID_W, dtype=jnp.float32), rows)
    gqa_ang_r = rope_angles(row_pos, GQA_HEAD_DIM // 2)
    gqa_ang_c = rope_angles(col_pos, GQA_HEAD_DIM // 2)
    mla_ang_r = rope_angles(row_pos, MLA_ROPE // 2)
    mla_ang_c = rope_angles(col_pos, MLA_ROPE // 2)
    split_idx = np.cumsum(IN_SIZES)[:-1].tolist()

    for l in range(DEPTH):
        x = x + 0.5 * swiglu_ffn(x, ffn1_norm[l], ffn1_wi[l], ffn1_wo[l])

        h = rmsnorm(x, mix_norm[l])
        (a_q, a_k, a_v, sc_u, c_qlat, c_kvlat, c_krope, lru_u, gate_lin) = jnp.split(
            h @ w_in[l], split_idx, axis=-1)
        o_a = gqa_mixer(a_q, a_k, a_v, gqa_q_norm[l], gqa_k_norm[l], gqa_ang_r, gqa_ang_c)
        o_b = shortconv_mixer(sc_u, sc_conv_w[l], sc_conv_b[l])
        o_c = mla_mixer(c_qlat, c_kvlat, c_krope, mla_qa_norm[l], mla_wq_up[l],
                        mla_kva_norm[l], mla_wkv_up[l], mla_q_norm[l], mla_k_norm[l],
                        mla_ang_r, mla_ang_c)
        o_d = rglru_mixer(lru_u, lru_conv_w[l], lru_conv_b[l], lru_wa[l], lru_ba[l],
                          lru_wx[l], lru_bx[l], lru_lambda[l])
        branches = jnp.stack([o_a, o_b, o_c, o_d], axis=2)
        y = jnp.einsum('bsnc,ncd->bsnd', branches, w_branch[l])
        g = jax.nn.sigmoid(gate_lin.reshape(b, s, N_BRANCH, d))
        merged = jnp.sum(g * y, axis=2)
        x = x + merged @ w_out[l]

        x = x + 0.5 * swiglu_ffn(x, ffn2_norm[l], ffn2_wi[l], ffn2_wo[l])
    return x
```

```cpp
#include <hip/hip_runtime.h>
#include <hip/hip_bf16.h>
#include <hip/hip_cooperative_groups.h>
#include <cstdio>
namespace cg = cooperative_groups;

typedef unsigned short u16;
using bf16x8 = __attribute__((ext_vector_type(8))) short;
using f32x4 = __attribute__((ext_vector_type(4))) float;
using f32x16 = __attribute__((ext_vector_type(16))) float;
typedef __bf16 bf16x2_t __attribute__((ext_vector_type(2)));
typedef float f32x2_t __attribute__((ext_vector_type(2)));
#define DI __device__ __forceinline__

constexpr int T_ = 32768, S_ = 16384, DM = 1024, DFF = 2816, NL = 4;
constexpr int UW = 4096;
constexpr int UQ = 0, UK = 512, UV = 640, USC = 768, UQLAT = 2304, UKVLAT = 2688, ULRU = 2944, UKROPE = 3968;
constexpr int NTHR = 512;
constexpr int MAXGRID = 256;

constexpr size_t O_WI1 = 0;
constexpr size_t O_WO1 = O_WI1 + (size_t)5632 * 1024;
constexpr size_t O_WIN = O_WO1 + (size_t)1024 * 2816;
constexpr size_t O_WQUP = O_WIN + (size_t)8192 * 1024;
constexpr size_t O_WKVUP = O_WQUP + (size_t)768 * 384;
constexpr size_t O_WBR = O_WKVUP + (size_t)1024 * 256;
constexpr size_t O_WOUT = O_WBR + (size_t)4 * 1024 * 512;
constexpr size_t O_WI2 = O_WOUT + (size_t)1024 * 1024;
constexpr size_t O_WO2 = O_WI2 + (size_t)5632 * 1024;
constexpr size_t W_ELEMS = O_WO2 + (size_t)1024 * 2816;

constexpr size_t AL(size_t x) { return (x + 255) & ~(size_t)255; }
constexpr size_t B_WB = 0;
constexpr size_t B_H = AL(B_WB + W_ELEMS * 2);
constexpr size_t B_U = AL(B_H + (size_t)T_ * 1024 * 2);
constexpr size_t B_R = AL(B_U + (size_t)T_ * UW * 2);
constexpr size_t B_QM = B_R;
constexpr size_t B_KVM = AL(B_QM + (size_t)T_ * 768 * 2);
constexpr size_t B_VTM = AL(B_KVM + (size_t)T_ * 1024 * 2);
constexpr size_t B_VTG = AL(B_VTM + (size_t)T_ * 512 * 2);
constexpr size_t B_MERGED = B_R;
constexpr size_t B_SCR = AL(B_MERGED + (size_t)T_ * 1024 * 2);
constexpr size_t SCR_PER_BLOCK = (size_t)NTHR * 192 * 4;
constexpr size_t B_REND1 = AL(B_VTG + (size_t)T_ * 128 * 2);
constexpr size_t B_REND2 = AL(B_SCR + SCR_PER_BLOCK * MAXGRID);
constexpr size_t B_SMALL = (B_REND1 > B_REND2 ? B_REND1 : B_REND2);
constexpr size_t B_TABG_R = B_SMALL;
constexpr size_t B_TABG_C = AL(B_TABG_R + 256 * 16 * 8);
constexpr size_t B_TABM_R = AL(B_TABG_C + 64 * 16 * 8);
constexpr size_t B_TABM_C = AL(B_TABM_R + 256 * 8 * 8);
constexpr size_t B_SUMM = AL(B_TABM_C + 64 * 8 * 8);
constexpr size_t B_CARRY = AL(B_SUMM + (size_t)2 * 2 * 256 * 512 * 8);
constexpr size_t B_BAR = AL(B_CARRY + (size_t)2 * 2 * 256 * 512 * 4);
constexpr size_t BAR_BYTES = 3456 * 4;
constexpr size_t B_END = AL(B_BAR + BAR_BYTES);

struct Params {
  const float* in[28];
  float* out;
  char* ws;
};

typedef const __attribute__((address_space(4))) Params CParams;

DI u16 f2bf(float x) { unsigned u = __float_as_uint(x); u += 0x7fffu + ((u >> 16) & 1u); return (u16)(u >> 16); }
DI float bf2f(u16 b) { return __uint_as_float(((unsigned)b) << 16); }
DI unsigned pack2(float a, float b) { f32x2_t v = {a, b}; bf16x2_t r = __builtin_convertvector(v, bf16x2_t); return __builtin_bit_cast(unsigned, r); }
DI float lo2f(unsigned p) { return __uint_as_float(p << 16); }
DI float hi2f(unsigned p) { return __uint_as_float(p & 0xffff0000u); }
DI float shx(float v, int o, int lane) { return __int_as_float(__builtin_amdgcn_ds_bpermute((lane ^ o) << 2, __float_as_int(v))); }
DI float wave_sum(float v, int lane) {
#pragma unroll
  for (int o = 32; o >= 1; o >>= 1) v += shx(v, o, lane);
  return v;
}
typedef unsigned v2u_t __attribute__((ext_vector_type(2)));
DI float wsum_dpp(float v) {
  v += __int_as_float(__builtin_amdgcn_update_dpp(0, __float_as_int(v), 0xB1, 0xF, 0xF, true));
  v += __int_as_float(__builtin_amdgcn_update_dpp(0, __float_as_int(v), 0x4E, 0xF, 0xF, true));
  v += __int_as_float(__builtin_amdgcn_update_dpp(0, __float_as_int(v), 0x141, 0xF, 0xF, true));
  v += __int_as_float(__builtin_amdgcn_update_dpp(0, __float_as_int(v), 0x140, 0xF, 0xF, true));
  v2u_t a = __builtin_amdgcn_permlane16_swap(__float_as_uint(v), __float_as_uint(v), false, false);
  v = __uint_as_float(a[0]) + __uint_as_float(a[1]);
  v2u_t b = __builtin_amdgcn_permlane32_swap(__float_as_uint(v), __float_as_uint(v), false, false);
  return __uint_as_float(b[0]) + __uint_as_float(b[1]);
}
DI float xor16_(float y, int lane) {
  v2u_t a = __builtin_amdgcn_permlane16_swap(__float_as_uint(y), __float_as_uint(y), false, false);
  return (lane & 16) ? __uint_as_float(a[0]) : __uint_as_float(a[1]);
}
DI float xor4_(float y) {
  float t = __int_as_float(__builtin_amdgcn_update_dpp(0, __float_as_int(y), 0x141, 0xF, 0xF, true));
  return __int_as_float(__builtin_amdgcn_update_dpp(0, __float_as_int(t), 0x1B, 0xF, 0xF, true));
}
DI float rcp_(float x) { return __builtin_amdgcn_rcpf(x); }
DI float sigmoidf_(float x) { return rcp_(1.f + __expf(-x)); }
DI float softplus_neg(float lm) {
  float e = __expf(-lm);
  return (e < 0.03f) ? e * (1.f - e * (0.5f - e * (1.f / 3.f - 0.25f * e))) : __logf(1.f + e);
}
DI float one_minus_exp(float z) {
  return (z > -0.25f) ? -z * (1.f + z * (0.5f + z * (1.f / 6.f + z * (1.f / 24.f + z * (1.f / 120.f))))) : 1.f - __expf(z);
}
DI float tanh_(float y) { return 1.f - 2.f * rcp_(1.f + __expf(2.f * y)); }
DI int tid_() { int t = threadIdx.x; asm volatile("" : "+v"(t)); return t; }
DI int permkey(int k) { return (k & ~12) | ((k & 4) << 1) | ((k & 8) >> 1); }

constexpr int BM = 256, BK = 64, HALF = 128, HT = HALF * BK;
DI int lds_byte(int r, int c) {
  int st = (r >> 4) * 2 + (c >> 5), rr = r & 15, cc = c & 31, ob = rr * 64 + cc * 2;
  return st * 1024 + (ob ^ (((ob >> 9) & 1) << 5));
}
DI void stage_rc(int b, int& R, int& C) {
  int st = b / 1024, sb = b % 1024, swz = sb ^ (((sb >> 9) & 1) << 5);
  R = (st >> 1) * 16 + swz / 64; C = (st & 1) * 32 + (swz % 64) / 2;
}

typedef f32x4 acc_t[4][4];
constexpr int BN = 128;

template <bool LOWREG = false, class Epi>
DI void gemm_tile(const u16* __restrict__ A, int lda, const u16* __restrict__ Bt, int ldb, int K, int brow, int bcol, Epi epi,
               bool preloaded = false, bool hasNext = false, int nbrow = 0, int nbcol = 0) {
  const int tid = tid_();
  extern __shared__ __attribute__((aligned(16))) char smem[];
  u16* shm = (u16*)smem;
#define SA(b, h) (shm + ((b) * 3 + (h)) * HT)
#define SB(b) (shm + ((b) * 3 + 2) * HT)
#define STAGE(P, BASE, LD, br, kt, O0, O1) do { const u16* _gb = (BASE) + (size_t)(br) * (LD) + (size_t)(kt) * BK; \
    __builtin_amdgcn_global_load_lds((const unsigned*)(_gb + (O0)), (__attribute__((address_space(3))) unsigned*)((char*)(P) + tid * 16), 16, 0, 0); \
    __builtin_amdgcn_global_load_lds((const unsigned*)(_gb + (O1)), (__attribute__((address_space(3))) unsigned*)((char*)(P) + tid * 16 + 8192), 16, 0, 0); } while (0)
#define STAGEA(P, br, kt) STAGE(P, A, lda, br, kt, oA0, oA1)
#define STAGEB(P, br, kt) STAGE(P, Bt, ldb, br, kt, oB0, oB1)
#define STAGE_ALL(bufi, kt) do { STAGEA(SA(bufi, 0), brow, kt); STAGEA(SA(bufi, 1), brow + HALF, kt); STAGEB(SB(bufi), bcol, kt); } while (0)
#define STAGE_NEXT(bufi, kt) do { STAGEA(SA(bufi, 0), nbrow, kt); STAGEA(SA(bufi, 1), nbrow + HALF, kt); STAGEB(SB(bufi), nbcol, kt); } while (0)
#define WAIT_V(n) asm volatile("s_waitcnt vmcnt(" #n ")" ::: "memory")
#define BAR __builtin_amdgcn_s_barrier()

  if (!preloaded) {
    asm volatile("s_waitcnt vmcnt(0)" ::: "memory");
    __syncthreads();
  }
  const int wid = tid >> 6, lane = tid & 63, wr = wid >> 1, wc = wid & 1, fr = lane & 15, fq = lane >> 4;
  acc_t acc;
#pragma unroll
  for (int m = 0; m < 4; ++m)
#pragma unroll
    for (int n = 0; n < 4; ++n) acc[m][n] = f32x4{0.f, 0.f, 0.f, 0.f};
  const int nt = K / BK;
  unsigned oA0, oA1, oB0, oB1;
  { int _r, _c; stage_rc(tid * 16, _r, _c); oA0 = _r * lda + _c; oB0 = _r * ldb + _c;
    stage_rc(tid * 16 + 8192, _r, _c); oA1 = _r * lda + _c; oB1 = _r * ldb + _c; }
  if (!preloaded) {
    STAGE_ALL(0, 0);
    if (nt > 1) STAGE_ALL(1, 1);
  }
  int b = 0;
  if (LOWREG) {
#pragma unroll 1
    for (int t = 0; t < nt; ++t) {
      if (t + 1 < nt) WAIT_V(6); else WAIT_V(0);
      BAR;
      if (t + 2 < nt) { const int b2 = (b == 0) ? 2 : b - 1; STAGE_ALL(b2, t + 2); }
      const char* pa = (const char*)SA(b, wr >> 1);
      const char* pb = (const char*)SB(b);
#pragma unroll
      for (int k = 0; k < 2; ++k) {
        bf16x8 At[4], Bf[4];
#pragma unroll
        for (int m = 0; m < 4; ++m) At[m] = *reinterpret_cast<const bf16x8*>(pa + lds_byte((wr & 1) * 64 + m * 16 + fr, k * 32 + fq * 8));
#pragma unroll
        for (int n = 0; n < 4; ++n) Bf[n] = *reinterpret_cast<const bf16x8*>(pb + lds_byte(wc * 64 + n * 16 + fr, k * 32 + fq * 8));
#pragma unroll
        for (int m = 0; m < 4; ++m)
#pragma unroll
          for (int n = 0; n < 4; ++n) acc[m][n] = __builtin_amdgcn_mfma_f32_16x16x32_bf16(Bf[n], At[m], acc[m][n], 0, 0, 0);
        __builtin_amdgcn_sched_barrier(0);
      }
      b = (b == 2) ? 0 : b + 1;
    }
  } else {
    const int grp = wid >> 2;
    if (!preloaded) {
      if (nt > 1) WAIT_V(6); else WAIT_V(0);
      __syncthreads();
    }
    if (grp == 1) BAR;
#pragma unroll 1
    for (int t = 0; t < nt; ++t) {
      const char* pa = (const char*)SA(b, wr >> 1);
      const char* pb = (const char*)SB(b);
      bf16x8 At[4][2], Bf[4][2];
#pragma unroll
      for (int m = 0; m < 4; ++m)
#pragma unroll
        for (int k = 0; k < 2; ++k) At[m][k] = *reinterpret_cast<const bf16x8*>(pa + lds_byte((wr & 1) * 64 + m * 16 + fr, k * 32 + fq * 8));
#pragma unroll
      for (int n = 0; n < 4; ++n)
#pragma unroll
        for (int k = 0; k < 2; ++k) Bf[n][k] = *reinterpret_cast<const bf16x8*>(pb + lds_byte(wc * 64 + n * 16 + fr, k * 32 + fq * 8));
      if (t + 2 < nt) { const int b2 = (b == 0) ? 2 : b - 1; STAGE_ALL(b2, t + 2); WAIT_V(6); } else { WAIT_V(0); }
      asm volatile("s_waitcnt lgkmcnt(0)" ::: "memory");
      __builtin_amdgcn_sched_barrier(0);
      BAR;
      __builtin_amdgcn_sched_barrier(0);
      const bool fillB = hasNext && grp == 1 && t == nt - 1;
      if (fillB) { STAGE_NEXT(0, 0); STAGE_NEXT(1, 1); }
      __builtin_amdgcn_s_setprio(1);
#pragma unroll
      for (int k = 0; k < 2; ++k)
#pragma unroll
        for (int m = 0; m < 4; ++m)
#pragma unroll
          for (int n = 0; n < 4; ++n) acc[m][n] = __builtin_amdgcn_mfma_f32_16x16x32_bf16(Bf[n][k], At[m][k], acc[m][n], 0, 0, 0);
      __builtin_amdgcn_s_setprio(0);
      if (fillB) WAIT_V(0);
      __builtin_amdgcn_sched_barrier(0);
      BAR;
      __builtin_amdgcn_sched_barrier(0);
      b = (b == 2) ? 0 : b + 1;
    }
    if (hasNext && grp == 0) { STAGE_NEXT(0, 0); STAGE_NEXT(1, 1); }
    epi(acc, brow, bcol);
    if (grp == 0) { if (hasNext) WAIT_V(0); BAR; }
  }
  if (LOWREG) epi(acc, brow, bcol);
#undef SA
#undef SB
}

#define EPI_IDS const int tid = tid_(); const int wid = tid >> 6, lane = tid & 63, wr = wid >> 1, wc = wid & 1, fr = lane & 15, fq = lane >> 4; (void)wr; (void)wc; (void)fr; (void)fq;

struct EpiStoreBf16 {
  u16* out; int ld;
  DI void operator()(acc_t& acc, int brow, int bcol) const {
    EPI_IDS
#pragma unroll
    for (int m = 0; m < 4; ++m)
#pragma unroll
      for (int n = 0; n < 4; ++n) {
        int row = brow + wr * 64 + m * 16 + fr, col = bcol + wc * 64 + n * 16 + fq * 4;
        uint2 v = {pack2(acc[m][n][0], acc[m][n][1]), pack2(acc[m][n][2], acc[m][n][3])};
        *(uint2*)(out + (unsigned)(row * ld + col)) = v;
      }
  }
};
struct EpiSwiglu {
  u16* out;
  DI void operator()(acc_t& acc, int brow, int bcol) const {
    EPI_IDS
    const int cb = (bcol >> 7) * 64 + wc * 32;
#pragma unroll
    for (int m = 0; m < 4; ++m)
#pragma unroll
      for (int n = 0; n < 2; ++n) {
        int row = brow + wr * 64 + m * 16 + fr, col = cb + n * 16 + fq * 4;
        float r[4];
#pragma unroll
        for (int j = 0; j < 4; ++j) { float g = acc[m][n][j], u = acc[m][n + 2][j]; r[j] = g * sigmoidf_(g) * u; }
        uint2 v = {pack2(r[0], r[1]), pack2(r[2], r[3])};
        *(uint2*)(out + (unsigned)(row * DFF + col)) = v;
      }
  }
};
struct EpiResid {
  float* x; float c;
  DI void operator()(acc_t& acc, int brow, int bcol) const {
    EPI_IDS
    f32x4 v[16];
#pragma unroll
    for (int m = 0; m < 4; ++m)
#pragma unroll
      for (int n = 0; n < 4; ++n) {
        const int row = brow + wr * 64 + m * 16 + fr, col = bcol + wc * 64 + n * 16 + fq * 4;
        v[m * 4 + n] = *(const f32x4*)(x + (unsigned)(row * DM + col));
      }
    asm volatile("" : "+v"(v[0]), "+v"(v[1]), "+v"(v[2]), "+v"(v[3]), "+v"(v[4]), "+v"(v[5]), "+v"(v[6]), "+v"(v[7]));
    asm volatile("" : "+v"(v[8]), "+v"(v[9]), "+v"(v[10]), "+v"(v[11]), "+v"(v[12]), "+v"(v[13]), "+v"(v[14]), "+v"(v[15]));
#pragma unroll
    for (int m = 0; m < 4; ++m)
#pragma unroll
      for (int n = 0; n < 4; ++n) {
        const int row = brow + wr * 64 + m * 16 + fr, col = bcol + wc * 64 + n * 16 + fq * 4;
        f32x4 w = v[m * 4 + n];
        w[0] += c * acc[m][n][0]; w[1] += c * acc[m][n][1]; w[2] += c * acc[m][n][2]; w[3] += c * acc[m][n][3];
        *(f32x4*)(x + (unsigned)(row * DM + col)) = w;
      }
  }
};
struct EpiGateReg {
  unsigned* gp;
  DI void operator()(acc_t& acc, int brow, int bcol) const {
    int e = 0;
#pragma unroll
    for (int m = 0; m < 4; ++m)
#pragma unroll
      for (int n = 0; n < 4; ++n)
#pragma unroll
        for (int j = 0; j < 4; j += 2) { gp[e] = pack2(sigmoidf_(acc[m][n][j]), sigmoidf_(acc[m][n][j + 1])); ++e; }
  }
};
struct EpiMergeReg {
  const unsigned* gp; unsigned* macc;
  DI void operator()(acc_t& acc, int brow, int bcol) const {
    int e = 0;
#pragma unroll
    for (int m = 0; m < 4; ++m)
#pragma unroll
      for (int n = 0; n < 4; ++n)
#pragma unroll
        for (int j = 0; j < 4; j += 2) {
          macc[e] = pack2(lo2f(macc[e]) + lo2f(gp[e]) * acc[m][n][j], hi2f(macc[e]) + hi2f(gp[e]) * acc[m][n][j + 1]);
          ++e;
        }
  }
};

DI void tile_map(int tile, int nM, int nN, int& pm, int& pn) {
  const int WGM = 8;
  int nig = WGM * nN, gid = tile / nig, fm = gid * WGM, gsz = min(nM - fm, WGM);
  pm = fm + ((tile % nig) % gsz); pn = (tile % nig) / gsz;
}

DI int map_col(int mode, int np) {
  if (mode == 0) return np;
  if (mode == 1) { int tile = np >> 7, wc = (np >> 6) & 1, half = (np >> 5) & 1, c = np & 31; return half * DFF + tile * 64 + wc * 32 + c; }
  if (np < 2944) return np;
  if (np < 3968) return np + 32;
  if (np < 4000) return np - 1024;
  if (np < 4096) return -1;
  return np - 96;
}
DI void conv_tile(const float* __restrict__ src, u16* __restrict__ dst, int K, int Nsrc, int mode, int tile) {
  const int tid = tid_();
  extern __shared__ __attribute__((aligned(16))) char smem[];
  float* ts = (float*)smem;
  const int nkt = K / 128;
  const int nt_ = tile / nkt, kt = tile % nkt;
  const int n0 = nt_ * 32, k0 = kt * 128;
  const int ns = map_col(mode, n0);
  __syncthreads();
  {
    int n = tid & 31, k = tid >> 5;
    float v[8];
#pragma unroll
    for (int p = 0; p < 8; ++p) v[p] = (ns >= 0) ? src[(size_t)(k0 + k + 16 * p) * Nsrc + ns + n] : 0.f;
#pragma unroll
    for (int p = 0; p < 8; ++p) ts[(k + 16 * p) * 33 + n] = v[p];
  }
  __syncthreads();
  {
    int n = tid >> 4, kc = (tid & 15) * 8;
    uint4 v;
    v.x = pack2(ts[(kc + 0) * 33 + n], ts[(kc + 1) * 33 + n]);
    v.y = pack2(ts[(kc + 2) * 33 + n], ts[(kc + 3) * 33 + n]);
    v.z = pack2(ts[(kc + 4) * 33 + n], ts[(kc + 5) * 33 + n]);
    v.w = pack2(ts[(kc + 6) * 33 + n], ts[(kc + 7) * 33 + n]);
    *(uint4*)(dst + (size_t)(n0 + n) * K + k0 + kc) = v;
  }
}
DI void phase_convert(CParams& p, int layer) {
  u16* wb = (u16*)(p.ws + B_WB);
  for (int item = blockIdx.x;; item += gridDim.x) {
    int t = item;
    const float* src; u16* dst; int K, Nsrc, Ndst, mode;
#define JOB(SRC, DST, K_, NSRC_, NDST_, MODE_) { int cnt = ((NDST_) / 32) * ((K_) / 128); if (t < cnt) { src = (SRC); dst = (DST); K = (K_); Nsrc = (NSRC_); Ndst = (NDST_); mode = (MODE_); goto found; } t -= cnt; }
    JOB(p.in[2] + (size_t)layer * 1024 * 5632, wb + O_WI1, 1024, 5632, 5632, 1)
    JOB(p.in[3] + (size_t)layer * 2816 * 1024, wb + O_WO1, 2816, 1024, 1024, 0)
    JOB(p.in[5] + (size_t)layer * 1024 * 8096, wb + O_WIN, 1024, 8096, 8192, 2)
    JOB(p.in[11] + (size_t)layer * 384 * 768, wb + O_WQUP, 384, 768, 768, 0)
    JOB(p.in[13] + (size_t)layer * 256 * 1024, wb + O_WKVUP, 256, 1024, 1024, 0)
    JOB(p.in[23] + (size_t)(layer * 4 + 0) * 512 * 1024, wb + O_WBR + (size_t)0 * 1024 * 512, 512, 1024, 1024, 0)
    JOB(p.in[23] + (size_t)(layer * 4 + 1) * 512 * 1024, wb + O_WBR + (size_t)1 * 1024 * 512, 512, 1024, 1024, 0)
    JOB(p.in[23] + (size_t)(layer * 4 + 2) * 512 * 1024, wb + O_WBR + (size_t)2 * 1024 * 512, 512, 1024, 1024, 0)
    JOB(p.in[23] + (size_t)(layer * 4 + 3) * 512 * 1024, wb + O_WBR + (size_t)3 * 1024 * 512, 512, 1024, 1024, 0)
    JOB(p.in[24] + (size_t)layer * 1024 * 1024, wb + O_WOUT, 1024, 1024, 1024, 0)
    JOB(p.in[26] + (size_t)layer * 1024 * 5632, wb + O_WI2, 1024, 5632, 5632, 1)
    JOB(p.in[27] + (size_t)layer * 2816 * 1024, wb + O_WO2, 2816, 1024, 1024, 0)
#undef JOB
    break;
  found:
    (void)Ndst;
    conv_tile(src, dst, K, Nsrc, mode, t);
  }
}

DI void phase_tables(CParams& p) {
  const int tid = tid_();
  float2* gr = (float2*)(p.ws + B_TABG_R); float2* gc = (float2*)(p.ws + B_TABG_C);
  float2* mr = (float2*)(p.ws + B_TABM_R); float2* mc = (float2*)(p.ws + B_TABM_C);
  int gt = blockIdx.x * NTHR + tid, gs = gridDim.x * NTHR;
  for (int i = gt; i < 256 * 16; i += gs) { int pos = i >> 4, f = i & 15; float inv = __builtin_amdgcn_exp2f(-(float)(2 * f) / 32.f * 13.287712379549449f); float a = (float)pos * inv; gr[i] = make_float2(__cosf(a), __sinf(a)); }
  for (int i = gt; i < 64 * 16; i += gs) { int pos = i >> 4, f = i & 15; float inv = __builtin_amdgcn_exp2f(-(float)(2 * f) / 32.f * 13.287712379549449f); float a = (float)pos * inv; gc[i] = make_float2(__cosf(a), __sinf(a)); }
  for (int i = gt; i < 256 * 8; i += gs) { int pos = i >> 3, f = i & 7; float inv = __builtin_amdgcn_exp2f(-(float)(2 * f) / 16.f * 13.287712379549449f); float a = (float)pos * inv; mr[i] = make_float2(__cosf(a), __sinf(a)); }
  for (int i = gt; i < 64 * 8; i += gs) { int pos = i >> 3, f = i & 7; float inv = __builtin_amdgcn_exp2f(-(float)(2 * f) / 16.f * 13.287712379549449f); float a = (float)pos * inv; mc[i] = make_float2(__cosf(a), __sinf(a)); }
}

DI void phase_norm(const float* __restrict__ xsrc, float* __restrict__ xcopy, const float* __restrict__ g, u16* __restrict__ h) {
  const int tid = tid_();
  const int wid = tid >> 6, lane = tid & 63;
  for (int row = blockIdx.x * 8 + wid; row < T_; row += gridDim.x * 8) {
    const float4* xr = (const float4*)(xsrc + (size_t)row * DM);
    float4 v[4]; float ss = 0.f;
#pragma unroll
    for (int i = 0; i < 4; ++i) { v[i] = xr[lane + 64 * i]; ss += v[i].x * v[i].x + v[i].y * v[i].y + v[i].z * v[i].z + v[i].w * v[i].w; }
    ss = wsum_dpp(ss);
    float rs = rsqrtf(ss * (1.f / DM) + 1e-6f);
#pragma unroll
    for (int i = 0; i < 4; ++i) {
      float4 gg = ((const float4*)g)[lane + 64 * i];
      uint2 o = {pack2(v[i].x * rs * gg.x, v[i].y * rs * gg.y), pack2(v[i].z * rs * gg.z, v[i].w * rs * gg.w)};
      *(uint2*)(h + (size_t)row * DM + (lane + 64 * i) * 4) = o;
      if (xcopy) ((float4*)(xcopy + (size_t)row * DM))[lane + 64 * i] = v[i];
    }
  }
}

DI bool tile_map_xcd(int bid, int nblk, int round, int nM, int nN, int& pm, int& pn) {
  if (nblk != 256 || nM != 128 || (nN & 3)) return false;
  const int xcd = bid & 7, loc = bid >> 3, lr = loc & 7, lc = loc >> 3;
  const int ncg = nN >> 2;
  const int cg = round % ncg, rg = round / ncg;
  pm = xcd + 8 * (rg * 8 + lr); pn = cg * 4 + lc;
  return true;
}
template <class Epi>
DI void gemm_phase(const u16* A, int lda, const u16* Bt, int ldb, int K, int M, int N, Epi epi, int first, int stride) {
  const int nM = M / BM, nN = N / BN, ntile = nM * nN;
  int round = 0, pm = 0, pn = 0;
  if (first < ntile) { if (!tile_map_xcd(first, stride, 0, nM, nN, pm, pn)) tile_map(first, nM, nN, pm, pn); }
  for (int tile = first; tile < ntile; tile += stride, ++round) {
    const int nxt = tile + stride;
    const bool hasNext = nxt < ntile;
    int qm = 0, qn = 0;
    if (hasNext) { if (!tile_map_xcd(first, stride, round + 1, nM, nN, qm, qn)) tile_map(nxt, nM, nN, qm, qn); }
    gemm_tile(A, lda, Bt, ldb, K, pm * BM, pn * BN, epi, round > 0, hasNext, qm * BM, qn * BN);
    pm = qm; pn = qn;
  }
}

struct PostTok { u16 rh[10], rq[6], rk[4]; uint4 bg, cg[3], xs[3]; float2 cs; };
DI void post_load(const u16* __restrict__ u, int t, int s, int lane, const float2* tgr, const float2* tgc, PostTok& d) {
  const u16* ur = u + (size_t)t * UW;
  const int rowp = s >> 6, colp = s & 63;
  d.cs = (lane < 32) ? tgr[rowp * 16 + (lane & 15)] : tgc[colp * 16 + (lane & 15)];
#pragma unroll
  for (int hd = 0; hd < 10; ++hd) d.rh[hd] = ur[hd * 64 + lane];
#pragma unroll
  for (int k = 0; k < 6; ++k) d.rq[k] = ur[UQLAT + lane + 64 * k];
#pragma unroll
  for (int k = 0; k < 4; ++k) d.rk[k] = ur[UKVLAT + lane + 64 * k];
  const int c0 = lane * 8;
  d.bg = *(const uint4*)(ur + USC + c0);
#pragma unroll
  for (int k = 0; k < 3; ++k) {
    const int s2 = s + k - 1;
    if (s2 >= 0 && s2 < S_) {
      const u16* r2 = u + (size_t)(t + k - 1) * UW + USC;
      d.cg[k] = *(const uint4*)(r2 + 512 + c0); d.xs[k] = *(const uint4*)(r2 + 1024 + c0);
    } else { d.cg[k] = uint4{0, 0, 0, 0}; d.xs[k] = uint4{0, 0, 0, 0}; }
  }
}
DI void post_tile(CParams& p, int layer, int tile) {
  const int tid = tid_();
  extern __shared__ __attribute__((aligned(16))) char smem[];
  u16* u = (u16*)(p.ws + B_U);
  const float2* tgr = (const float2*)(p.ws + B_TABG_R); const float2* tgc = (const float2*)(p.ws + B_TABG_C);
  const int wid = tid >> 6, lane = tid & 63;
  const int tb = tile * 64;
  const int b = tb / S_, sb = tb % S_;
  const float* qn = p.in[6] + layer * 64; const float* kn = p.in[7] + layer * 64;
  const float* scw = p.in[8] + layer * 3 * 512; const float* scb = p.in[9] + layer * 512;
  const float* qan = p.in[10] + layer * 384; const float* kvan = p.in[12] + layer * 256;
  const float gq = qn[lane], gk = kn[lane];
  float qanr[6], kvanr[4], scwr[3][8], scbr[8];
#pragma unroll
  for (int k = 0; k < 6; ++k) qanr[k] = qan[lane + 64 * k];
#pragma unroll
  for (int k = 0; k < 4; ++k) kvanr[k] = kvan[lane + 64 * k];
#pragma unroll
  for (int e = 0; e < 8; ++e) { scbr[e] = scb[lane * 8 + e];
#pragma unroll
    for (int k = 0; k < 3; ++k) scwr[k][e] = scw[k * 512 + lane * 8 + e]; }
  __syncthreads();
  PostTok dA, dB;
  post_load(u, tb + wid * 8, sb + wid * 8, lane, tgr, tgc, dA);
#pragma unroll
  for (int i = 0; i < 8; ++i) {
    PostTok& d = (i & 1) ? dB : dA;
    PostTok& dn = (i & 1) ? dA : dB;
    const int tl = wid * 8 + i, t = tb + tl, s = sb + tl;
    if (i + 1 < 8) post_load(u, t + 1, s + 1, lane, tgr, tgc, dn);
    u16* ur = u + (size_t)t * UW;
    const float2 cs = d.cs;
    float xh[10], ss[12];
#pragma unroll
    for (int hd = 0; hd < 10; ++hd) { xh[hd] = bf2f(d.rh[hd]); ss[hd] = xh[hd] * xh[hd]; }
    float xq[6], xk[4];
    ss[10] = 0.f; ss[11] = 0.f;
#pragma unroll
    for (int k = 0; k < 6; ++k) { xq[k] = bf2f(d.rq[k]); ss[10] += xq[k] * xq[k]; }
#pragma unroll
    for (int k = 0; k < 4; ++k) { xk[k] = bf2f(d.rk[k]); ss[11] += xk[k] * xk[k]; }
#pragma unroll
    for (int c = 0; c < 12; ++c) ss[c] = wsum_dpp(ss[c]);
    float yh[10], prh[10];
#pragma unroll
    for (int hd = 0; hd < 10; ++hd) yh[hd] = xh[hd] * rsqrtf(ss[hd] * (1.f / 64.f) + 1e-6f) * (hd < 8 ? gq : gk);
#pragma unroll
    for (int hd = 0; hd < 10; ++hd) prh[hd] = xor16_(yh[hd], lane);
#pragma unroll
    for (int hd = 0; hd < 10; ++hd) {
      float o = yh[hd] * cs.x + ((lane & 16) ? prh[hd] : -prh[hd]) * cs.y;
      if (hd < 8) o *= 0.125f * 1.4426950408889634f;
      ur[hd * 64 + lane] = f2bf(o);
    }
    {
      float rs = rsqrtf(ss[10] * (1.f / 384.f) + 1e-6f);
#pragma unroll
      for (int k = 0; k < 6; ++k) ur[UQLAT + lane + 64 * k] = f2bf(xq[k] * rs * qanr[k]);
      float rs2 = rsqrtf(ss[11] * (1.f / 256.f) + 1e-6f);
#pragma unroll
      for (int k = 0; k < 4; ++k) ur[UKVLAT + lane + 64 * k] = f2bf(xk[k] * rs2 * kvanr[k]);
    }
    {
      const int c0 = lane * 8;
      float accv[8];
#pragma unroll
      for (int e = 0; e < 8; ++e) accv[e] = scbr[e];
#pragma unroll
      for (int k = 0; k < 3; ++k) {
        const unsigned cgs[4] = {d.cg[k].x, d.cg[k].y, d.cg[k].z, d.cg[k].w}; const unsigned xss[4] = {d.xs[k].x, d.xs[k].y, d.xs[k].z, d.xs[k].w};
#pragma unroll
        for (int e = 0; e < 4; ++e) {
          accv[2 * e] += scwr[k][2 * e] * (lo2f(cgs[e]) * lo2f(xss[e]));
          accv[2 * e + 1] += scwr[k][2 * e + 1] * (hi2f(cgs[e]) * hi2f(xss[e]));
        }
      }
      const uint4 bg = d.bg;
      uint4 o;
      o.x = pack2(lo2f(bg.x) * accv[0], hi2f(bg.x) * accv[1]);
      o.y = pack2(lo2f(bg.y) * accv[2], hi2f(bg.y) * accv[3]);
      o.z = pack2(lo2f(bg.z) * accv[4], hi2f(bg.z) * accv[5]);
      o.w = pack2(lo2f(bg.w) * accv[6], hi2f(bg.w) * accv[7]);
      *(uint4*)(ur + USC + c0) = o;
    }
  }
  {
    u16* ls = (u16*)smem;
    int tok = tid >> 3, ch = tid & 7;
    const u16* src = u + (size_t)(tb + tok) * UW + UV + ch * 16;
    uint4 a = *(const uint4*)src, c = *(const uint4*)(src + 8);
    const unsigned w[8] = {a.x, a.y, a.z, a.w, c.x, c.y, c.z, c.w};
    int pt = permkey(tok);
#pragma unroll
    for (int e = 0; e < 8; ++e) {
      ls[(ch * 16 + 2 * e) * 72 + pt] = (u16)(w[e] & 0xffff);
      ls[(ch * 16 + 2 * e + 1) * 72 + pt] = (u16)(w[e] >> 16);
    }
    __syncthreads();
    u16* vtg = (u16*)(p.ws + B_VTG);
#pragma unroll
    for (int k = 0; k < 2; ++k) {
      int idx = tid + 512 * k, row = idx >> 3, c8 = idx & 7;
      uint4 v = *(const uint4*)(ls + row * 72 + c8 * 8);
      *(uint4*)(vtg + ((size_t)(b * 2 + (row >> 6)) * 64 + (row & 63)) * S_ + sb + c8 * 8) = v;
    }
  }
}

DI void lru_phase(CParams& p, int layer, int pass, int bid, int nblk, unsigned* qctr = nullptr, volatile unsigned __attribute__((address_space(3)))* qslot = nullptr) {
  const int tid = tid_();
  extern __shared__ __attribute__((aligned(16))) char smem[];
  u16* xcb = (u16*)smem;
  float* xcf = (float*)(smem + 64 * 72 * 2);
  float* G = xcf + 64 * 64;
  float2* part = (float2*)(G + 4 * 64 * 64);
  u16* u = (u16*)(p.ws + B_U);
  const float* cw = p.in[16] + layer * 4 * 512; const float* cb = p.in[17] + layer * 512;
  const float* lam = p.in[22] + (size_t)layer * 2 * 512;
  const int wid = tid >> 6, lane = tid & 63;
  const int mi = wid >> 1, dh = wid & 1, r = lane & 31, hh = lane >> 5, mdir = mi >> 1;
  const int ctok = tid >> 3, ccg = (tid & 7) * 8;
  const int ec = tid & 63;
  const int sdir = tid >> 8, ssub = (tid >> 6) & 3;
  int nbPrev = -1;
  bf16x8 wf[4]; float bs = 0.f, sp0 = 0.f, sp1 = 0.f;
  float cwr[4][8], cbr[8];
  const int qcls = (bid >> 3) & 7;
#pragma unroll 1
  for (int item = bid;; item += nblk) {
    if (qctr) {
      if (tid == 0) *qslot = atomicAdd(qctr + qcls, 1u);
      __syncthreads();
      const unsigned tk = *qslot;
      if (tk >= 512u) break;
      item = (int)tk * 8 + qcls;
    } else if (item >= 4096) break;
    const int nb = item & 7, j = (item >> 3) & 255, b = item >> 11;
    const int c0 = nb * 64, s0 = j * 64;
    if (nb != nbPrev) {
      nbPrev = nb;
      const float* W = ((mi & 1) ? p.in[20] : p.in[18]) + ((size_t)((layer * 2 + mdir) * 8 + nb)) * 64 * 64;
      const float* bias = ((mi & 1) ? p.in[21] : p.in[19]) + (size_t)(layer * 2 + mdir) * 512 + c0;
#pragma unroll
      for (int ks = 0; ks < 4; ++ks) {
        unsigned bw[4];
#pragma unroll
        for (int jj = 0; jj < 4; ++jj) {
          float w0 = W[(16 * ks + 8 * hh + 2 * jj) * 64 + 32 * dh + r];
          float w1 = W[(16 * ks + 8 * hh + 2 * jj + 1) * 64 + 32 * dh + r];
          bw[jj] = pack2(w0, w1);
        }
        uint4 bq = {bw[0], bw[1], bw[2], bw[3]};
        wf[ks] = __builtin_bit_cast(bf16x8, bq);
      }
      bs = bias[32 * dh + r];
      sp0 = softplus_neg(lam[c0 + ec]); sp1 = softplus_neg(lam[512 + c0 + ec]);
#pragma unroll
      for (int e = 0; e < 8; ++e) {
        cbr[e] = cb[c0 + ccg + e];
#pragma unroll
        for (int k = 0; k < 4; ++k) cwr[k][e] = cw[k * 512 + c0 + ccg + e];
      }
    }
    __syncthreads();
    {
      float a[8];
#pragma unroll
      for (int e = 0; e < 8; ++e) a[e] = cbr[e];
#pragma unroll
      for (int k = 0; k < 4; ++k) {
        int s2 = s0 + ctok + k - 2;
        if (s2 >= 0 && s2 < S_) {
          uint4 xv = *(const uint4*)(u + (size_t)(b * S_ + s2) * UW + ULRU + 512 + c0 + ccg);
          const unsigned w[4] = {xv.x, xv.y, xv.z, xv.w};
#pragma unroll
          for (int e = 0; e < 4; ++e) {
            a[2 * e] += cwr[k][2 * e] * lo2f(w[e]);
            a[2 * e + 1] += cwr[k][2 * e + 1] * hi2f(w[e]);
          }
        }
      }
#pragma unroll
      for (int e = 0; e < 8; ++e) xcf[ctok * 64 + ccg + e] = a[e];
      uint4 o = {pack2(a[0], a[1]), pack2(a[2], a[3]), pack2(a[4], a[5]), pack2(a[6], a[7])};
      *(uint4*)(xcb + ctok * 72 + ccg) = o;
    }
    u16* gp = u + (size_t)(b * S_ + s0 + ctok) * UW + ULRU + c0 + ccg;
    uint4 gv = {0, 0, 0, 0};
    if (pass == 3) gv = *(const uint4*)gp;
    __syncthreads();
    {
      f32x16 acc0, acc1;
#pragma unroll
      for (int i = 0; i < 16; ++i) { acc0[i] = 0.f; acc1[i] = 0.f; }
#pragma unroll
      for (int ks = 0; ks < 4; ++ks) {
        bf16x8 a0 = *(const bf16x8*)(xcb + (r)*72 + 16 * ks + 8 * hh);
        bf16x8 a1 = *(const bf16x8*)(xcb + (32 + r) * 72 + 16 * ks + 8 * hh);
        acc0 = __builtin_amdgcn_mfma_f32_32x32x16_bf16(a0, wf[ks], acc0, 0, 0, 0);
        acc1 = __builtin_amdgcn_mfma_f32_32x32x16_bf16(a1, wf[ks], acc1, 0, 0, 0);
      }
#pragma unroll
      for (int i = 0; i < 16; ++i) {
        int row = (i & 3) + 8 * (i >> 2) + 4 * hh;
        G[(mi * 64 + row) * 64 + 32 * dh + r] = sigmoidf_(acc0[i] + bs);
        G[(mi * 64 + 32 + row) * 64 + 32 * dh + r] = sigmoidf_(acc1[i] + bs);
      }
    }
    __syncthreads();
    {
#pragma unroll
      for (int k = 0; k < 16; ++k) {
        const int dir = k >> 3, tok = (tid >> 6) + 8 * (k & 7);
        const float sp = dir ? sp1 : sp0;
        float rr = G[((2 * dir) * 64 + tok) * 64 + ec], ii = G[((2 * dir + 1) * 64 + tok) * 64 + ec];
        float la = -8.f * rr * sp;
        float av = __expf(la);
        float mult = __builtin_amdgcn_sqrtf(one_minus_exp(2.f * la));
        G[((2 * dir) * 64 + tok) * 64 + ec] = av;
        G[((2 * dir + 1) * 64 + tok) * 64 + ec] = mult * ii * xcf[tok * 64 + ec];
      }
    }
    __syncthreads();
    {
      float* Ga = G + (2 * sdir) * 4096; float* Gb = G + (2 * sdir + 1) * 4096;
      const int tb = ssub * 16;
      float hv = 0.f, P = 1.f;
#pragma unroll
      for (int k = 0; k < 16; ++k) { int t = tb + (sdir ? 15 - k : k); float a = Ga[t * 64 + ec]; hv = a * hv + Gb[t * 64 + ec]; P *= a; }
      part[(sdir * 4 + ssub) * 64 + ec] = make_float2(P, hv);
      __syncthreads();
      const size_t sidx = ((size_t)((b * 2 + sdir) * 256 + j)) * 512 + c0 + ec;
      if (pass == 1) {
        if (ssub == 0) {
          float Pt = 1.f, ht = 0.f;
#pragma unroll
          for (int q = 0; q < 4; ++q) { float2 pq = part[(sdir * 4 + (sdir ? 3 - q : q)) * 64 + ec]; ht = pq.x * ht + pq.y; Pt *= pq.x; }
          ((float2*)(p.ws + B_SUMM))[sidx] = make_float2(Pt, ht);
        }
      } else {
        float cin = ((const float*)(p.ws + B_CARRY))[sidx];
#pragma unroll
        for (int q = 0; q < 3; ++q) {
          const int sq = sdir ? 3 - q : q;
          const bool before = sdir ? (sq > ssub) : (sq < ssub);
          float2 pq = part[(sdir * 4 + sq) * 64 + ec];
          if (before) cin = pq.x * cin + pq.y;
        }
        hv = cin;
#pragma unroll
        for (int k = 0; k < 16; ++k) { int t = tb + (sdir ? 15 - k : k); float a = Ga[t * 64 + ec]; hv = a * hv + Gb[t * 64 + ec]; Gb[t * 64 + ec] = hv; }
      }
    }
    if (pass == 3) {
      __syncthreads();
      const unsigned w[4] = {gv.x, gv.y, gv.z, gv.w};
      float o[8];
#pragma unroll
      for (int e = 0; e < 8; ++e) {
        float g = (e & 1) ? hi2f(w[e >> 1]) : lo2f(w[e >> 1]);
        float ge = 0.5f * g * (1.f + tanh_(0.7978845608028654f * (g + 0.044715f * g * g * g)));
        o[e] = ge * (G[(1 * 64 + ctok) * 64 + ccg + e] + G[(3 * 64 + ctok) * 64 + ccg + e]);
      }
      uint4 ov = {pack2(o[0], o[1]), pack2(o[2], o[3]), pack2(o[4], o[5]), pack2(o[6], o[7])};
      *(uint4*)gp = ov;
    }
  }
}
DI void lru_carry(CParams& p, int blk) {
  const int tid = tid_();
  int id = blk * NTHR + tid;
  int c = id & 511, dir = (id >> 9) & 1, b = id >> 10;
  const float2* __restrict__ sm = (const float2*)(p.ws + B_SUMM) + (size_t)(b * 2 + dir) * 256 * 512 + c;
  float* __restrict__ cr = (float*)(p.ws + B_CARRY) + (size_t)(b * 2 + dir) * 256 * 512 + c;
  float cin = 0.f;
#pragma unroll 1
  for (int k0 = 0; k0 < 256; k0 += 32) {
    float2 ab[32];
#pragma unroll
    for (int i = 0; i < 32; ++i) { const int j = dir ? 255 - (k0 + i) : (k0 + i); ab[i] = sm[(size_t)j * 512]; }
#pragma unroll
    for (int i = 0; i < 32; ++i) {
      const int j = dir ? 255 - (k0 + i) : (k0 + i);
      cr[(size_t)j * 512] = cin;
      cin = ab[i].x * cin + ab[i].y;
    }
  }
}

template <int D>
DI void attn_tile(const u16* __restrict__ Qp, int ldq, const u16* __restrict__ Kp, int ldk, const u16* __restrict__ Vt,
                  u16* __restrict__ Op, int ldo, int q0, float cs, float mc) {
  const int tid = tid_();
  extern __shared__ __attribute__((aligned(16))) char smem[];
  constexpr int KS = D * 2 + 16, VS = 144, KB = 64 * KS, VB = 64 * VS, BUF = KB + VB;
  constexpr int NKS = D / 16, CPR = D / 8;
  constexpr int NIT = S_ / 64;
  const int wid = tid >> 6, lane = tid & 63, r = lane & 31, hh = lane >> 5, grp = wid >> 2;
  __syncthreads();
  bf16x8 qf[NKS];
  {
    const u16* qr = Qp + (size_t)(q0 + wid * 32 + r) * ldq + 8 * hh;
#pragma unroll
    for (int ks = 0; ks < NKS; ++ks) qf[ks] = *(const bf16x8*)(qr + 16 * ks);
  }
  f32x16 o0, o1, s0, s1;
#pragma unroll
  for (int i = 0; i < 16; ++i) { o0[i] = 0.f; o1[i] = 0.f; }
  float lsum0 = 0.f, lsum1 = 0.f;
  uint4 kr0, kr1, vr;
  const int vrow = tid >> 3, vch = tid & 7;
  int krow0, kch0, krow1 = 0, kch1 = 0;
  if (D == 64) { krow0 = tid >> 3; kch0 = tid & 7; }
  else { krow0 = tid / CPR; kch0 = tid % CPR; int i2 = tid + 512; krow1 = i2 / CPR; kch1 = i2 % CPR; }
  const bool k2 = (D == 96) && (tid < 256);
  kr1 = uint4{0, 0, 0, 0};
#define LOADT(key0) do { kr0 = *(const uint4*)(Kp + (size_t)((key0) + krow0) * ldk + kch0 * 8); \
    if (k2) kr1 = *(const uint4*)(Kp + (size_t)((key0) + krow1) * ldk + kch1 * 8); \
    vr = *(const uint4*)(Vt + (size_t)vrow * S_ + (key0) + vch * 8); } while (0)
#define STORET(bufi) do { char* bb = smem + (bufi) * BUF; *(uint4*)(bb + krow0 * KS + kch0 * 16) = kr0; \
    if (k2) *(uint4*)(bb + krow1 * KS + kch1 * 16) = kr1; \
    *(uint4*)(bb + KB + vrow * VS + vch * 16) = vr; } while (0)
#define LOADKF(bufi) do { const char* kb_ = smem + (bufi) * BUF + r * KS + 16 * hh; \
    _Pragma("unroll") for (int ks = 0; ks < NKS; ++ks) { kf0[ks] = *(const bf16x8*)(kb_ + 32 * ks); kf1[ks] = *(const bf16x8*)(kb_ + 32 * KS + 32 * ks); } } while (0)
#define SMMA() do { const f32x16 z_ = {0.f, 0.f, 0.f, 0.f, 0.f, 0.f, 0.f, 0.f, 0.f, 0.f, 0.f, 0.f, 0.f, 0.f, 0.f, 0.f}; \
    s0 = __builtin_amdgcn_mfma_f32_32x32x16_bf16(kf0[0], qf[0], z_, 0, 0, 0); \
    s1 = __builtin_amdgcn_mfma_f32_32x32x16_bf16(kf1[0], qf[0], z_, 0, 0, 0); \
    _Pragma("unroll") for (int ks = 1; ks < NKS; ++ks) { s0 = __builtin_amdgcn_mfma_f32_32x32x16_bf16(kf0[ks], qf[ks], s0, 0, 0, 0); \
      s1 = __builtin_amdgcn_mfma_f32_32x32x16_bf16(kf1[ks], qf[ks], s1, 0, 0, 0); } } while (0)
#define BARX do { __builtin_amdgcn_sched_barrier(0); asm volatile("s_waitcnt lgkmcnt(0)" ::: "memory"); __builtin_amdgcn_s_barrier(); __builtin_amdgcn_sched_barrier(0); } while (0)
  bf16x8 kf0[NKS], kf1[NKS];
  LOADT(0); STORET(0);
  LOADT(64); STORET(1);
  __syncthreads();
  LOADT(128);
  LOADKF(0);
  SMMA();
  if (grp == 1) BARX;
#pragma unroll 1
  for (int it = 0; it < NIT; ++it) {
    bf16x8 pf[2][2];
    if (mc != 0.f) {
#pragma unroll
      for (int i = 0; i < 16; ++i) { s0[i] -= mc; s1[i] -= mc; }
    }
#pragma unroll
    for (int i = 0; i < 16; ++i) {
      s0[i] = __builtin_amdgcn_exp2f(s0[i]); s1[i] = __builtin_amdgcn_exp2f(s1[i]);
      lsum0 += s0[i]; lsum1 += s1[i];
    }
#pragma unroll
    for (int st = 0; st < 2; ++st) {
      uint4 a = {pack2(s0[8 * st], s0[8 * st + 1]), pack2(s0[8 * st + 2], s0[8 * st + 3]), pack2(s0[8 * st + 4], s0[8 * st + 5]), pack2(s0[8 * st + 6], s0[8 * st + 7])};
      uint4 c = {pack2(s1[8 * st], s1[8 * st + 1]), pack2(s1[8 * st + 2], s1[8 * st + 3]), pack2(s1[8 * st + 4], s1[8 * st + 5]), pack2(s1[8 * st + 6], s1[8 * st + 7])};
      pf[0][st] = __builtin_bit_cast(bf16x8, a); pf[1][st] = __builtin_bit_cast(bf16x8, c);
    }
    if (it + 2 < NIT) STORET((it + 2) & 3);
    if (it + 3 < NIT) LOADT((it + 3) * 64);
    if (it + 1 < NIT) LOADKF((it + 1) & 3);
    BARX;
    __builtin_amdgcn_s_setprio(1);
    {
      const char* vb = smem + (it & 3) * BUF + KB + r * VS + 16 * hh;
      bf16x8 v0[2], v1[2];
#pragma unroll
      for (int q = 0; q < 2; ++q) { v0[q] = *(const bf16x8*)(vb + 32 * q); v1[q] = *(const bf16x8*)(vb + 32 * VS + 32 * q); }
      if (it + 1 < NIT) SMMA();
#pragma unroll
      for (int q = 0; q < 2; ++q) {
        o0 = __builtin_amdgcn_mfma_f32_32x32x16_bf16(v0[q], pf[0][q], o0, 0, 0, 0);
        o1 = __builtin_amdgcn_mfma_f32_32x32x16_bf16(v1[q], pf[0][q], o1, 0, 0, 0);
      }
#pragma unroll
      for (int q = 0; q < 2; ++q) { v0[q] = *(const bf16x8*)(vb + 64 + 32 * q); v1[q] = *(const bf16x8*)(vb + 32 * VS + 64 + 32 * q); }
#pragma unroll
      for (int q = 0; q < 2; ++q) {
        o0 = __builtin_amdgcn_mfma_f32_32x32x16_bf16(v0[q], pf[1][q], o0, 0, 0, 0);
        o1 = __builtin_amdgcn_mfma_f32_32x32x16_bf16(v1[q], pf[1][q], o1, 0, 0, 0);
      }
    }
    __builtin_amdgcn_s_setprio(0);
    BARX;
  }
  if (grp == 0) BARX;
#undef LOADT
#undef STORET
#undef LOADKF
#undef SMMA
#undef BARX
  float lsum = lsum0 + lsum1;
  lsum += shx(lsum, 32, lane);
  const float inv = rcp_(lsum);
  u16* orow = Op + (size_t)(q0 + wid * 32 + r) * ldo;
#pragma unroll
  for (int g = 0; g < 4; ++g) {
    uint2 a = {pack2(o0[4 * g] * inv, o0[4 * g + 1] * inv), pack2(o0[4 * g + 2] * inv, o0[4 * g + 3] * inv)};
    uint2 c = {pack2(o1[4 * g] * inv, o1[4 * g + 1] * inv), pack2(o1[4 * g + 2] * inv, o1[4 * g + 3] * inv)};
    *(uint2*)(orow + 8 * g + 4 * hh) = a;
    *(uint2*)(orow + 32 + 8 * g + 4 * hh) = c;
  }
}

DI float gain_absmax(const float* g, int n) {
  float m = 0.f;
  for (int i = 0; i < n; ++i) m = fmaxf(m, fabsf(g[i]));
  return m;
}

struct MlaTok { unsigned qw[8], kw[8]; float2 c0, c1; };
DI void mla_load(const u16* __restrict__ u, const u16* __restrict__ qm, const u16* __restrict__ kvm, int t, int s, int lane, int e0, bool rl,
                 const float2* tmr, const float2* tmc, MlaTok& d) {
  const int rowp = s >> 6, colp = s & 63;
  d.c0 = float2{1.f, 0.f}; d.c1 = float2{1.f, 0.f};
  if (rl) {
    if (e0 < 16) { d.c0 = tmr[rowp * 8 + (e0 & 7)]; d.c1 = tmr[rowp * 8 + ((e0 + 1) & 7)]; }
    else { d.c0 = tmc[colp * 8 + (e0 & 7)]; d.c1 = tmc[colp * 8 + ((e0 + 1) & 7)]; }
  }
  const unsigned kro = rl ? *(const unsigned*)(u + (size_t)t * UW + UKROPE + e0) : 0u;
#pragma unroll
  for (int hd = 0; hd < 8; ++hd) {
    d.qw[hd] = (lane < 48) ? *(const unsigned*)(qm + (size_t)t * 768 + hd * 96 + 2 * lane) : 0u;
    d.kw[hd] = (lane < 32) ? *(const unsigned*)(kvm + (size_t)t * 1024 + hd * 128 + 2 * lane) : kro;
  }
}
DI void mla_post_tile(CParams& p, int layer, int tile) {
  const int tid = tid_();
  extern __shared__ __attribute__((aligned(16))) char smem[];
  u16* ls = (u16*)smem;
  u16* u = (u16*)(p.ws + B_U); u16* qm = (u16*)(p.ws + B_QM); u16* kvm = (u16*)(p.ws + B_KVM); u16* vtm = (u16*)(p.ws + B_VTM);
  const float2* tmr = (const float2*)(p.ws + B_TABM_R); const float2* tmc = (const float2*)(p.ws + B_TABM_C);
  const float* qn = p.in[14] + layer * 96; const float* kn = p.in[15] + layer * 96;
  const int wid = tid >> 6, lane = tid & 63;
  const int tb = tile * 64, b = tb / S_, sb = tb % S_;
  __syncthreads();
#pragma unroll
  for (int k = 0; k < 8; ++k) {
    int idx = tid + 512 * k, tok = idx >> 6, cc = idx & 63, hd = cc >> 3, dvc = (cc & 7) * 8;
    uint4 v = *(const uint4*)(kvm + (size_t)(tb + tok) * 1024 + hd * 128 + 64 + dvc);
    const unsigned w[4] = {v.x, v.y, v.z, v.w};
    int pt = permkey(tok);
#pragma unroll
    for (int e = 0; e < 4; ++e) {
      ls[(hd * 64 + dvc + 2 * e) * 72 + pt] = (u16)(w[e] & 0xffff);
      ls[(hd * 64 + dvc + 2 * e + 1) * 72 + pt] = (u16)(w[e] >> 16);
    }
  }
  __syncthreads();
  const int e0 = 2 * (lane - 32);
  const bool rl = lane >= 32 && lane < 48;
  float gq0 = 0.f, gq1 = 0.f, gk0 = 0.f, gk1 = 0.f;
  if (lane < 48) { gq0 = qn[2 * lane]; gq1 = qn[2 * lane + 1]; gk0 = kn[2 * lane]; gk1 = kn[2 * lane + 1]; }
  MlaTok mA, mB;
  mla_load(u, qm, kvm, tb + wid * 8, sb + wid * 8, lane, e0, rl, tmr, tmc, mA);
#pragma unroll
  for (int i = 0; i < 8; ++i) {
    MlaTok& d = (i & 1) ? mB : mA;
    MlaTok& dn = (i & 1) ? mA : mB;
    const int tl = wid * 8 + i, t = tb + tl;
    if (i + 1 < 8) mla_load(u, qm, kvm, t + 1, sb + tl + 1, lane, e0, rl, tmr, tmc, dn);
    const float2 c0 = d.c0, c1 = d.c1;
    float ss[16];
#pragma unroll
    for (int hd = 0; hd < 8; ++hd) {
      float a0 = lo2f(d.qw[hd]), a1 = hi2f(d.qw[hd]), b0 = lo2f(d.kw[hd]), b1 = hi2f(d.kw[hd]);
      ss[hd] = a0 * a0 + a1 * a1; ss[8 + hd] = b0 * b0 + b1 * b1;
    }
#pragma unroll
    for (int c = 0; c < 16; ++c) ss[c] = wsum_dpp(ss[c]);
    const float qsc = (1.f / 9.797958971132712f) * 1.4426950408889634f;
    const bool up = (e0 & 8) != 0;
#pragma unroll
    for (int hd = 0; hd < 8; ++hd) {
      {
        float rs = rsqrtf(ss[hd] * (1.f / 96.f) + 1e-6f);
        float y0 = lo2f(d.qw[hd]) * rs * gq0, y1 = hi2f(d.qw[hd]) * rs * gq1;
        float p0 = xor4_(y0), p1 = xor4_(y1);
        if (rl) { y0 = y0 * c0.x + (up ? p0 : -p0) * c0.y; y1 = y1 * c1.x + (up ? p1 : -p1) * c1.y; }
        if (lane < 48) *(unsigned*)(qm + (size_t)t * 768 + hd * 96 + 2 * lane) = pack2(y0 * qsc, y1 * qsc);
      }
      {
        float rs = rsqrtf(ss[8 + hd] * (1.f / 96.f) + 1e-6f);
        float y0 = lo2f(d.kw[hd]) * rs * gk0, y1 = hi2f(d.kw[hd]) * rs * gk1;
        float p0 = xor4_(y0), p1 = xor4_(y1);
        if (rl) { y0 = y0 * c0.x + (up ? p0 : -p0) * c0.y; y1 = y1 * c1.x + (up ? p1 : -p1) * c1.y; }
        if (lane < 48) *(unsigned*)(kvm + (size_t)t * 1024 + hd * 128 + 2 * lane) = pack2(y0, y1);
      }
    }
  }
#pragma unroll
  for (int k = 0; k < 8; ++k) {
    int idx = tid + 512 * k, row = idx >> 3, c8 = idx & 7;
    uint4 v = *(const uint4*)(ls + row * 72 + c8 * 8);
    *(uint4*)(vtm + ((size_t)(b * 8 + (row >> 6)) * 64 + (row & 63)) * S_ + sb + c8 * 8) = v;
  }
}


#define XB_TMO      128
#define XB_XCNT(j)  (256  + 64 * (j))
#define XB_XSUB(j)  (1280 + 64 * (j))
#define XB_XGEN(j)  (2304 + 64 * (j))
#define XB_TOP      3328
#define XB_TOPGEN   3392
#define XB_SPIN_CAP (1u << 24)
#define LAS __attribute__((address_space(3)))
DI unsigned xb_ld(unsigned* p) { return __hip_atomic_load(p, __ATOMIC_RELAXED, __HIP_MEMORY_SCOPE_AGENT); }
DI unsigned xb_add(unsigned* p, unsigned v) { return __hip_atomic_fetch_add(p, v, __ATOMIC_RELAXED, __HIP_MEMORY_SCOPE_AGENT); }
DI unsigned xb_xcc_id() { return (unsigned)__builtin_amdgcn_s_getreg((3 << 11) | 20) & 0xFu; }
#define XB_SPIN(cond, bar) do { unsigned _sp = 0; while (cond) { __builtin_amdgcn_s_sleep(1); \
    if ((++_sp & 255u) == 0u) { if (xb_ld(&(bar)[XB_TMO])) break; if (_sp > XB_SPIN_CAP) { atomicAdd(&(bar)[XB_TMO], 1u); break; } } } } while (0)
struct XcdBarrier { unsigned* bar; unsigned x; volatile LAS unsigned* st; };
DI XcdBarrier xcd_barrier_post(unsigned* bar, volatile LAS unsigned* st) {
  XcdBarrier b; b.bar = bar; b.x = xb_xcc_id(); b.st = st;
  if (threadIdx.x == 0) (void)xb_add(&bar[XB_XCNT(b.x)], 1u);
  return b;
}
DI void xcd_barrier_complete(unsigned* bar, unsigned x, unsigned& nloc, unsigned& nx) {
  const unsigned G = gridDim.x * gridDim.y * gridDim.z;
  unsigned sum, cnt, mine, sp = 0u;
  for (;;) {
    sum = 0u; cnt = 0u; mine = 0u;
#pragma unroll
    for (unsigned j = 0; j < 16; ++j) { const unsigned c = xb_ld(&bar[XB_XCNT(j)]); sum += c; cnt += (c > 0u) ? 1u : 0u; mine = (j == x) ? c : mine; }
    if (sum == G) break;
    __builtin_amdgcn_s_sleep(1);
    if ((++sp & 255u) == 0u) { if (xb_ld(&bar[XB_TMO])) break; if (sp > XB_SPIN_CAP) { atomicAdd(&bar[XB_TMO], 1u); break; } }
  }
  nloc = mine > 0u ? mine : 1u; nx = cnt > 0u ? cnt : 1u;
}
DI void xcd_barrier(const XcdBarrier& b) {
  asm volatile("s_waitcnt vmcnt(0)" ::: "memory");
  __syncthreads();
  if (threadIdx.x == 0) {
    unsigned* bar = b.bar;
    __builtin_amdgcn_s_waitcnt(0);
    unsigned nloc = b.st[0], nx = b.st[1];
    if (nloc == 0u) { xcd_barrier_complete(bar, b.x, nloc, nx); b.st[0] = nloc; b.st[1] = nx; }
    const unsigned old = xb_add(&bar[XB_XSUB(b.x)], 1u);
    const unsigned gen = old / nloc;
    if (old + 1u == (gen + 1u) * nloc) {
      __builtin_amdgcn_fence(__ATOMIC_RELEASE, "agent");
      asm volatile("s_waitcnt vmcnt(0)" ::: "memory");
      const unsigned og = xb_add(&bar[XB_TOP], 1u);
      const unsigned tg = og / nx;
      if (og + 1u == (tg + 1u) * nx) xb_add(&bar[XB_TOPGEN], 1u);
      else XB_SPIN(xb_ld(&bar[XB_TOPGEN]) == tg, bar);
      __builtin_amdgcn_fence(__ATOMIC_ACQUIRE, "agent");
      xb_add(&bar[XB_XGEN(b.x)], 1u);
      asm volatile("s_waitcnt vmcnt(0)" ::: "memory");
    } else {
      XB_SPIN(xb_ld(&bar[XB_XGEN(b.x)]) == gen, bar);
      __builtin_amdgcn_fence(__ATOMIC_ACQUIRE, "agent");
      asm volatile("s_waitcnt vmcnt(0)" ::: "memory");
    }
  }
  __syncthreads();
}

__global__ void __launch_bounds__(NTHR) fwd_megakernel(Params p_unused) {
  cg::grid_group grid = cg::this_grid();
  __shared__ uint4 xb_words;
  if (threadIdx.x == 0) xb_words = make_uint4(0u, 0u, 0u, 0u);
  __syncthreads();
  XcdBarrier xb = xcd_barrier_post((unsigned*)(((CParams*)__builtin_amdgcn_kernarg_segment_ptr())->ws + B_BAR), (volatile LAS unsigned*)&xb_words);
  grid.sync();
  const float LOG2E = 1.4426950408889634f;
  constexpr int NPH = 14;
#pragma unroll 1
  for (int step = 0; step < NL * NPH; ++step) {
    int layer = step / NPH; const int ph = step % NPH;
    asm volatile("" : "+s"(layer));
    int bid = blockIdx.x, nblk = gridDim.x;
    asm volatile("" : "+s"(bid)); asm volatile("" : "+s"(nblk));
    CParams* pp = (CParams*)__builtin_amdgcn_kernarg_segment_ptr();
    asm volatile("" : "+s"(pp));
    CParams& p = *pp;
    u16* wb = (u16*)(p.ws + B_WB);
    u16* h = (u16*)(p.ws + B_H);
    u16* u = (u16*)(p.ws + B_U);
    float* x = p.out;
    switch (ph) {
      case 0: {
        if (layer == 0) phase_tables(p);
        phase_convert(p, layer);
        phase_norm(layer == 0 ? p.in[0] : x, layer == 0 ? x : nullptr, p.in[1] + layer * DM, h);
      } break;
      case 1: gemm_phase(h, DM, wb + O_WI1, DM, DM, T_, 2 * DFF, EpiSwiglu{u}, bid, nblk); break;
      case 2: gemm_phase(u, DFF, wb + O_WO1, DFF, DFF, T_, DM, EpiResid{x, 0.5f}, bid, nblk); break;
      case 3: phase_norm(x, nullptr, p.in[4] + layer * DM, h); break;
      case 4: gemm_phase(h, DM, wb + O_WIN, DM, DM, T_, UW, EpiStoreBf16{u, UW}, bid, nblk); break;
      case 5: {
        for (int it = bid; it < 512; it += nblk) post_tile(p, layer, it);
        lru_phase(p, layer, 1, bid, nblk);
      } break;
      case 6: {
        u16* qm = (u16*)(p.ws + B_QM); u16* kvm = (u16*)(p.ws + B_KVM); u16* vtg = (u16*)(p.ws + B_VTG);
        if (bid < 4) lru_carry(p, bid);
        float mcg = 8.f * gain_absmax(p.in[6] + layer * 64, 64) * gain_absmax(p.in[7] + layer * 64, 64) * LOG2E;
        if (mcg < 60.f) mcg = 0.f;
        const float csg = 0.125f * LOG2E;
        for (int it = bid; it < 1024; it += nblk) {
          int g = it & 3, qt = (it >> 2) & 63, kvh = (it >> 8) & 1, b = it >> 9;
          int hq = kvh * 4 + g;
          attn_tile<64>(u + (size_t)b * S_ * UW + UQ + hq * 64, UW, u + (size_t)b * S_ * UW + UK + kvh * 64, UW,
                        vtg + (size_t)(b * 2 + kvh) * 64 * S_, u + (size_t)b * S_ * UW + UQ + hq * 64, UW, qt * 256, csg, mcg);
        }
        {
          unsigned* qc = (unsigned*)(p.ws + B_BAR) + 1 + layer * 9 + 8;
          volatile LAS unsigned* qslot = (volatile LAS unsigned*)&xb_words.z;
          for (;;) {
            if (threadIdx.x == 0) *qslot = atomicAdd(qc, 1u);
            __syncthreads();
            const int tk = (int)*qslot;
            if (tk >= 768 + 1024) break;
            if (tk < 768) {
              int pm, pn; tile_map(tk, 128, 6, pm, pn);
              gemm_tile(u + UQLAT, UW, wb + O_WQUP, 384, 384, pm * BM, pn * BN, EpiStoreBf16{qm, 768});
            } else {
              int pm, pn; tile_map(tk - 768, 128, 8, pm, pn);
              gemm_tile(u + UKVLAT, UW, wb + O_WKVUP, 256, 256, pm * BM, pn * BN, EpiStoreBf16{kvm, 1024});
            }
          }
        }
      } break;
      case 7: {
        for (int it = bid; it < 512; it += nblk) mla_post_tile(p, layer, it);
      } break;
      case 8: {
        u16* qm = (u16*)(p.ws + B_QM); u16* kvm = (u16*)(p.ws + B_KVM); u16* vtm = (u16*)(p.ws + B_VTM);
        const float sq96 = 9.797958971132712f;
        float mcm = sq96 * gain_absmax(p.in[14] + layer * 96, 96) * gain_absmax(p.in[15] + layer * 96, 96) * LOG2E;
        if (mcm < 60.f) mcm = 0.f;
        const float csm = (1.f / sq96) * LOG2E;
        for (int it = bid; it < 1024; it += nblk) {
          int qt = it & 63, hd = (it >> 6) & 7, b = it >> 9;
          attn_tile<96>(qm + (size_t)b * S_ * 768 + hd * 96, 768, kvm + (size_t)b * S_ * 1024 + hd * 128, 1024,
                        vtm + (size_t)(b * 8 + hd) * 64 * S_, u + (size_t)b * S_ * UW + UQLAT + hd * 64, UW, qt * 256, csm, mcm);
        }
        lru_phase(p, layer, 3, bid, nblk, (unsigned*)(p.ws + B_BAR) + 1 + layer * 9, (volatile LAS unsigned*)&xb_words.z);
      } break;
      case 9: {
        u16* merged = (u16*)(p.ws + B_MERGED);
        int round9 = 0;
        for (int tile = bid; tile < 128 * 8; tile += nblk, ++round9) {
          int pm, pn;
          if (!tile_map_xcd(bid, nblk, round9, 128, 8, pm, pn)) tile_map(tile, 128, 8, pm, pn);
          unsigned macc[32];
#pragma unroll
          for (int e = 0; e < 32; ++e) macc[e] = 0u;
#pragma unroll 1
          for (int n = 0; n < 4; ++n) {
            const int brc = (n == 0) ? UQ : (n == 1) ? USC : (n == 2) ? UQLAT : ULRU;
            unsigned gp[32];
            gemm_tile<false>(h, DM, wb + O_WIN + (size_t)(4096 + n * 1024) * DM, DM, DM, pm * BM, pn * BN, EpiGateReg{gp});
            gemm_tile<false>(u + brc, UW, wb + O_WBR + (size_t)n * 1024 * 512, 512, 512, pm * BM, pn * BN, EpiMergeReg{gp, macc});
          }
          {
            const int tid = tid_();
            const int wid = tid >> 6, lane = tid & 63, wr = wid >> 1, wc = wid & 1, fr = lane & 15, fq = lane >> 4;
#pragma unroll
            for (int m = 0; m < 4; ++m)
#pragma unroll
              for (int n = 0; n < 4; ++n) {
                const int e = (m * 4 + n) * 2;
                int row = pm * BM + wr * 64 + m * 16 + fr, col = pn * BN + wc * 64 + n * 16 + fq * 4;
                uint2 v = {macc[e], macc[e + 1]};
                *(uint2*)(merged + (unsigned)(row * DM + col)) = v;
              }
          }
        }
      } break;
      case 10: gemm_phase((u16*)(p.ws + B_MERGED), DM, wb + O_WOUT, DM, DM, T_, DM, EpiResid{x, 1.0f}, bid, nblk); break;
      case 11: phase_norm(x, nullptr, p.in[25] + layer * DM, h); break;
      case 12: gemm_phase(h, DM, wb + O_WI2, DM, DM, T_, 2 * DFF, EpiSwiglu{u}, bid, nblk); break;
      case 13: gemm_phase(u, DFF, wb + O_WO2, DFF, DFF, T_, DM, EpiResid{x, 0.5f}, bid, nblk); break;
    }
    xcd_barrier(xb);
  }
}

constexpr size_t kDynLds = 147456;

extern "C" void kernel_launch(void* const* d_in, const int* in_sizes, int n_in, void* d_out, int out_size, void* d_ws, size_t ws_size,
                              hipStream_t stream) {
  static int grid_blocks = 0;
  if (!grid_blocks) {
    int dev = 0, cus = 0, per_cu = 0;
    hipGetDevice(&dev);
    hipDeviceGetAttribute(&cus, hipDeviceAttributeMultiprocessorCount, dev);
    hipFuncSetAttribute((const void*)fwd_megakernel, hipFuncAttributeMaxDynamicSharedMemorySize, (int)kDynLds);
    hipOccupancyMaxActiveBlocksPerMultiprocessor(&per_cu, fwd_megakernel, NTHR, kDynLds);
    if (per_cu < 1) per_cu = 1;
    grid_blocks = cus * per_cu;
    if (grid_blocks > MAXGRID) grid_blocks = MAXGRID;
    if (B_END > ws_size) fprintf(stderr, "workspace too small: need %zu have %zu\n", (size_t)B_END, ws_size);
  }
  Params p{};
  for (int i = 0; i < 28; ++i) p.in[i] = (const float*)d_in[i];
  p.out = (float*)d_out;
  p.ws = (char*)d_ws;
  (void)hipMemsetAsync((char*)d_ws + B_BAR, 0, BAR_BYTES, stream);
  void* args[] = {&p};
  hipError_t e = hipLaunchCooperativeKernel((void*)fwd_megakernel, dim3(grid_blocks), dim3(NTHR), args, kDynLds, stream);
  if (e != hipSuccess) fprintf(stderr, "cooperative launch failed: %s (grid %d)\n", hipGetErrorString(e), grid_blocks);
}
```

```cpp
#include <hip/hip_runtime.h>
#include <hip/hip_bf16.h>
#include <hip/hip_cooperative_groups.h>
#include <cstdio>
namespace cg = cooperative_groups;

typedef unsigned short u16;
using bf16x8 = __attribute__((ext_vector_type(8))) short;
using f32x4 = __attribute__((ext_vector_type(4))) float;
using f32x16 = __attribute__((ext_vector_type(16))) float;
typedef __bf16 bf16x2_t __attribute__((ext_vector_type(2)));
typedef float f32x2_t __attribute__((ext_vector_type(2)));
#define DI __device__ __forceinline__

constexpr int T_ = 32768, S_ = 16384, DM = 1024, DFF = 2816, NL = 4;
constexpr int UW = 4096;
constexpr int UQ = 0, UK = 512, UV = 640, USC = 768, UQLAT = 2304, UKVLAT = 2688, ULRU = 2944, UKROPE = 3968;
constexpr int NTHR = 512;
constexpr int MAXGRID = 256;

constexpr size_t O_WI1 = 0;
constexpr size_t O_WO1 = O_WI1 + (size_t)5632 * 1024;
constexpr size_t O_WIN = O_WO1 + (size_t)1024 * 2816;
constexpr size_t O_WQUP = O_WIN + (size_t)8192 * 1024;
constexpr size_t O_WKVUP = O_WQUP + (size_t)768 * 384;
constexpr size_t O_WBR = O_WKVUP + (size_t)1024 * 256;
constexpr size_t O_WOUT = O_WBR + (size_t)4 * 1024 * 512;
constexpr size_t O_WI2 = O_WOUT + (size_t)1024 * 1024;
constexpr size_t O_WO2 = O_WI2 + (size_t)5632 * 1024;
constexpr size_t W_ELEMS = O_WO2 + (size_t)1024 * 2816;

constexpr size_t AL(size_t x) { return (x + 255) & ~(size_t)255; }
constexpr size_t B_WB = 0;
constexpr size_t B_H = AL(B_WB + W_ELEMS * 2);
constexpr size_t B_U = AL(B_H + (size_t)T_ * 1024 * 2);
constexpr size_t B_R = AL(B_U + (size_t)T_ * UW * 2);
constexpr size_t B_QM = B_R;
constexpr size_t B_KVM = AL(B_QM + (size_t)T_ * 768 * 2);
constexpr size_t B_VTM = AL(B_KVM + (size_t)T_ * 1024 * 2);
constexpr size_t B_VTG = AL(B_VTM + (size_t)T_ * 512 * 2);
constexpr size_t B_MERGED = B_R;
constexpr size_t B_SCR = AL(B_MERGED + (size_t)T_ * 1024 * 2);
constexpr size_t SCR_PER_BLOCK = (size_t)NTHR * 192 * 4;
constexpr size_t B_REND1 = AL(B_VTG + (size_t)T_ * 128 * 2);
constexpr size_t B_REND2 = AL(B_SCR + SCR_PER_BLOCK * MAXGRID);
constexpr size_t B_SMALL = (B_REND1 > B_REND2 ? B_REND1 : B_REND2);
constexpr size_t B_TABG_R = B_SMALL;
constexpr size_t B_TABG_C = AL(B_TABG_R + 256 * 16 * 8);
constexpr size_t B_TABM_R = AL(B_TABG_C + 64 * 16 * 8);
constexpr size_t B_TABM_C = AL(B_TABM_R + 256 * 8 * 8);
constexpr size_t B_SUMM = AL(B_TABM_C + 64 * 8 * 8);
constexpr size_t B_CARRY = AL(B_SUMM + (size_t)2 * 2 * 256 * 512 * 8);
constexpr size_t B_BAR = AL(B_CARRY + (size_t)2 * 2 * 256 * 512 * 4);
constexpr size_t BAR_BYTES = 3456 * 4;
constexpr size_t B_END = AL(B_BAR + BAR_BYTES);

struct Params {
  const float* in[28];
  float* out;
  char* ws;
};

typedef const __attribute__((address_space(4))) Params CParams;

DI u16 f2bf(float x) { unsigned u = __float_as_uint(x); u += 0x7fffu + ((u >> 16) & 1u); return (u16)(u >> 16); }
DI float bf2f(u16 b) { return __uint_as_float(((unsigned)b) << 16); }
DI unsigned pack2(float a, float b) { f32x2_t v = {a, b}; bf16x2_t r = __builtin_convertvector(v, bf16x2_t); return __builtin_bit_cast(unsigned, r); }
DI float lo2f(unsigned p) { return __uint_as_float(p << 16); }
DI float hi2f(unsigned p) { return __uint_as_float(p & 0xffff0000u); }
DI float shx(float v, int o, int lane) { return __int_as_float(__builtin_amdgcn_ds_bpermute((lane ^ o) << 2, __float_as_int(v))); }
DI float wave_sum(float v, int lane) {
#pragma unroll
  for (int o = 32; o >= 1; o >>= 1) v += shx(v, o, lane);
  return v;
}
typedef unsigned v2u_t __attribute__((ext_vector_type(2)));
DI float wsum_dpp(float v) {
  v += __int_as_float(__builtin_amdgcn_update_dpp(0, __float_as_int(v), 0xB1, 0xF, 0xF, true));
  v += __int_as_float(__builtin_amdgcn_update_dpp(0, __float_as_int(v), 0x4E, 0xF, 0xF, true));
  v += __int_as_float(__builtin_amdgcn_update_dpp(0, __float_as_int(v), 0x141, 0xF, 0xF, true));
  v += __int_as_float(__builtin_amdgcn_update_dpp(0, __float_as_int(v), 0x140, 0xF, 0xF, true));
  v2u_t a = __builtin_amdgcn_permlane16_swap(__float_as_uint(v), __float_as_uint(v), false, false);
  v = __uint_as_float(a[0]) + __uint_as_float(a[1]);
  v2u_t b = __builtin_amdgcn_permlane32_swap(__float_as_uint(v), __float_as_uint(v), false, false);
  return __uint_as_float(b[0]) + __uint_as_float(b[1]);
}
DI float xor16_(float y, int lane) {
  v2u_t a = __builtin_amdgcn_permlane16_swap(__float_as_uint(y), __float_as_uint(y), false, false);
  return (lane & 16) ? __uint_as_float(a[0]) : __uint_as_float(a[1]);
}
DI float xor4_(float y) {
  float t = __int_as_float(__builtin_amdgcn_update_dpp(0, __float_as_int(y), 0x141, 0xF, 0xF, true));
  return __int_as_float(__builtin_amdgcn_update_dpp(0, __float_as_int(t), 0x1B, 0xF, 0xF, true));
}
DI float rcp_(float x) { return __builtin_amdgcn_rcpf(x); }
DI float sigmoidf_(float x) { return rcp_(1.f + __expf(-x)); }
DI float softplus_neg(float lm) {
  float e = __expf(-lm);
  return (e < 0.03f) ? e * (1.f - e * (0.5f - e * (1.f / 3.f - 0.25f * e))) : __logf(1.f + e);
}
DI float one_minus_exp(float z) {
  return (z > -0.25f) ? -z * (1.f + z * (0.5f + z * (1.f / 6.f + z * (1.f / 24.f + z * (1.f / 120.f))))) : 1.f - __expf(z);
}
DI float tanh_(float y) { return 1.f - 2.f * rcp_(1.f + __expf(2.f * y)); }
DI int tid_() { int t = threadIdx.x; asm volatile("" : "+v"(t)); return t; }
DI int permkey(int k) { return (k & ~12) | ((k & 4) << 1) | ((k & 8) >> 1); }

constexpr int BM = 256, BK = 64, HALF = 128, HT = HALF * BK;
DI int lds_byte(int r, int c) {
  int st = (r >> 4) * 2 + (c >> 5), rr = r & 15, cc = c & 31, ob = rr * 64 + cc * 2;
  return st * 1024 + (ob ^ (((ob >> 9) & 1) << 5));
}
DI void stage_rc(int b, int& R, int& C) {
  int st = b / 1024, sb = b % 1024, swz = sb ^ (((sb >> 9) & 1) << 5);
  R = (st >> 1) * 16 + swz / 64; C = (st & 1) * 32 + (swz % 64) / 2;
}

typedef f32x4 acc_t[4][4];
constexpr int BN = 128;

template <bool LOWREG = false, class Epi>
DI void gemm_tile(const u16* __restrict__ A, int lda, const u16* __restrict__ Bt, int ldb, int K, int brow, int bcol, Epi epi,
               bool preloaded = false, bool hasNext = false, int nbrow = 0, int nbcol = 0) {
  const int tid = tid_();
  extern __shared__ __attribute__((aligned(16))) char smem[];
  u16* shm = (u16*)smem;
#define SA(b, h) (shm + ((b) * 3 + (h)) * HT)
#define SB(b) (shm + ((b) * 3 + 2) * HT)
#define STAGE(P, BASE, LD, br, kt, O0, O1) do { const u16* _gb = (BASE) + (size_t)(br) * (LD) + (size_t)(kt) * BK; \
    __builtin_amdgcn_global_load_lds((const unsigned*)(_gb + (O0)), (__attribute__((address_space(3))) unsigned*)((char*)(P) + tid * 16), 16, 0, 0); \
    __builtin_amdgcn_global_load_lds((const unsigned*)(_gb + (O1)), (__attribute__((address_space(3))) unsigned*)((char*)(P) + tid * 16 + 8192), 16, 0, 0); } while (0)
#define STAGEA(P, br, kt) STAGE(P, A, lda, br, kt, oA0, oA1)
#define STAGEB(P, br, kt) STAGE(P, Bt, ldb, br, kt, oB0, oB1)
#define STAGE_ALL(bufi, kt) do { STAGEA(SA(bufi, 0), brow, kt); STAGEA(SA(bufi, 1), brow + HALF, kt); STAGEB(SB(bufi), bcol, kt); } while (0)
#define STAGE_NEXT(bufi, kt) do { STAGEA(SA(bufi, 0), nbrow, kt); STAGEA(SA(bufi, 1), nbrow + HALF, kt); STAGEB(SB(bufi), nbcol, kt); } while (0)
#define WAIT_V(n) asm volatile("s_waitcnt vmcnt(" #n ")" ::: "memory")
#define BAR __builtin_amdgcn_s_barrier()

  if (!preloaded) {
    asm volatile("s_waitcnt vmcnt(0)" ::: "memory");
    __syncthreads();
  }
  const int wid = tid >> 6, lane = tid & 63, wr = wid >> 1, wc = wid & 1, fr = lane & 15, fq = lane >> 4;
  acc_t acc;
#pragma unroll
  for (int m = 0; m < 4; ++m)
#pragma unroll
    for (int n = 0; n < 4; ++n) acc[m][n] = f32x4{0.f, 0.f, 0.f, 0.f};
  const int nt = K / BK;
  unsigned oA0, oA1, oB0, oB1;
  { int _r, _c; stage_rc(tid * 16, _r, _c); oA0 = _r * lda + _c; oB0 = _r * ldb + _c;
    stage_rc(tid * 16 + 8192, _r, _c); oA1 = _r * lda + _c; oB1 = _r * ldb + _c; }
  if (!preloaded) {
    STAGE_ALL(0, 0);
    if (nt > 1) STAGE_ALL(1, 1);
  }
  int b = 0;
  if (LOWREG) {
#pragma unroll 1
    for (int t = 0; t < nt; ++t) {
      if (t + 1 < nt) WAIT_V(6); else WAIT_V(0);
      BAR;
      if (t + 2 < nt) { const int b2 = (b == 0) ? 2 : b - 1; STAGE_ALL(b2, t + 2); }
      const char* pa = (const char*)SA(b, wr >> 1);
      const char* pb = (const char*)SB(b);
#pragma unroll
      for (int k = 0; k < 2; ++k) {
        bf16x8 At[4], Bf[4];
#pragma unroll
        for (int m = 0; m < 4; ++m) At[m] = *reinterpret_cast<const bf16x8*>(pa + lds_byte((wr & 1) * 64 + m * 16 + fr, k * 32 + fq * 8));
#pragma unroll
        for (int n = 0; n < 4; ++n) Bf[n] = *reinterpret_cast<const bf16x8*>(pb + lds_byte(wc * 64 + n * 16 + fr, k * 32 + fq * 8));
#pragma unroll
        for (int m = 0; m < 4; ++m)
#pragma unroll
          for (int n = 0; n < 4; ++n) acc[m][n] = __builtin_amdgcn_mfma_f32_16x16x32_bf16(Bf[n], At[m], acc[m][n], 0, 0, 0);
        __builtin_amdgcn_sched_barrier(0);
      }
      b = (b == 2) ? 0 : b + 1;
    }
  } else {
    const int grp = wid >> 2;
    if (nt > 1 && !preloaded) WAIT_V(6); else WAIT_V(0);
    __syncthreads();
    if (grp == 1) BAR;
#pragma unroll 1
    for (int t = 0; t < nt; ++t) {
      const char* pa = (const char*)SA(b, wr >> 1);
      const char* pb = (const char*)SB(b);
      bf16x8 At[4][2], Bf[4][2];
#pragma unroll
      for (int m = 0; m < 4; ++m)
#pragma unroll
        for (int k = 0; k < 2; ++k) At[m][k] = *reinterpret_cast<const bf16x8*>(pa + lds_byte((wr & 1) * 64 + m * 16 + fr, k * 32 + fq * 8));
#pragma unroll
      for (int n = 0; n < 4; ++n)
#pragma unroll
        for (int k = 0; k < 2; ++k) Bf[n][k] = *reinterpret_cast<const bf16x8*>(pb + lds_byte(wc * 64 + n * 16 + fr, k * 32 + fq * 8));
      if (t + 2 < nt) { const int b2 = (b == 0) ? 2 : b - 1; STAGE_ALL(b2, t + 2); WAIT_V(6); } else { WAIT_V(0); }
      asm volatile("s_waitcnt lgkmcnt(0)" ::: "memory");
      __builtin_amdgcn_sched_barrier(0);
      BAR;
      __builtin_amdgcn_sched_barrier(0);
      __builtin_amdgcn_s_setprio(1);
#pragma unroll
      for (int k = 0; k < 2; ++k)
#pragma unroll
        for (int m = 0; m < 4; ++m)
#pragma unroll
          for (int n = 0; n < 4; ++n) acc[m][n] = __builtin_amdgcn_mfma_f32_16x16x32_bf16(Bf[n][k], At[m][k], acc[m][n], 0, 0, 0);
      __builtin_amdgcn_s_setprio(0);
      __builtin_amdgcn_sched_barrier(0);
      BAR;
      __builtin_amdgcn_sched_barrier(0);
      b = (b == 2) ? 0 : b + 1;
    }
    if (hasNext) {
      STAGE_NEXT(0, 0);
      if (nt > 1) STAGE_NEXT(1, 1);
    }
    epi(acc, brow, bcol);
    if (grp == 0) BAR;
  }
  if (LOWREG) epi(acc, brow, bcol);
#undef SA
#undef SB
}

#define EPI_IDS const int tid = tid_(); const int wid = tid >> 6, lane = tid & 63, wr = wid >> 1, wc = wid & 1, fr = lane & 15, fq = lane >> 4; (void)wr; (void)wc; (void)fr; (void)fq;

struct EpiStoreBf16 {
  u16* out; int ld;
  DI void operator()(acc_t& acc, int brow, int bcol) const {
    EPI_IDS
#pragma unroll
    for (int m = 0; m < 4; ++m)
#pragma unroll
      for (int n = 0; n < 4; ++n) {
        int row = brow + wr * 64 + m * 16 + fr, col = bcol + wc * 64 + n * 16 + fq * 4;
        uint2 v = {pack2(acc[m][n][0], acc[m][n][1]), pack2(acc[m][n][2], acc[m][n][3])};
        *(uint2*)(out + (unsigned)(row * ld + col)) = v;
      }
  }
};
struct EpiSwiglu {
  u16* out;
  DI void operator()(acc_t& acc, int brow, int bcol) const {
    EPI_IDS
    const int cb = (bcol >> 7) * 64 + wc * 32;
#pragma unroll
    for (int m = 0; m < 4; ++m)
#pragma unroll
      for (int n = 0; n < 2; ++n) {
        int row = brow + wr * 64 + m * 16 + fr, col = cb + n * 16 + fq * 4;
        float r[4];
#pragma unroll
        for (int j = 0; j < 4; ++j) { float g = acc[m][n][j], u = acc[m][n + 2][j]; r[j] = g * sigmoidf_(g) * u; }
        uint2 v = {pack2(r[0], r[1]), pack2(r[2], r[3])};
        *(uint2*)(out + (unsigned)(row * DFF + col)) = v;
      }
  }
};
struct EpiResid {
  float* x; float c;
  DI void operator()(acc_t& acc, int brow, int bcol) const {
    EPI_IDS
    f32x4 v[16];
#pragma unroll
    for (int m = 0; m < 4; ++m)
#pragma unroll
      for (int n = 0; n < 4; ++n) {
        const int row = brow + wr * 64 + m * 16 + fr, col = bcol + wc * 64 + n * 16 + fq * 4;
        v[m * 4 + n] = *(const f32x4*)(x + (unsigned)(row * DM + col));
      }
    asm volatile("" : "+v"(v[0]), "+v"(v[1]), "+v"(v[2]), "+v"(v[3]), "+v"(v[4]), "+v"(v[5]), "+v"(v[6]), "+v"(v[7]));
    asm volatile("" : "+v"(v[8]), "+v"(v[9]), "+v"(v[10]), "+v"(v[11]), "+v"(v[12]), "+v"(v[13]), "+v"(v[14]), "+v"(v[15]));
#pragma unroll
    for (int m = 0; m < 4; ++m)
#pragma unroll
      for (int n = 0; n < 4; ++n) {
        const int row = brow + wr * 64 + m * 16 + fr, col = bcol + wc * 64 + n * 16 + fq * 4;
        f32x4 w = v[m * 4 + n];
        w[0] += c * acc[m][n][0]; w[1] += c * acc[m][n][1]; w[2] += c * acc[m][n][2]; w[3] += c * acc[m][n][3];
        *(f32x4*)(x + (unsigned)(row * DM + col)) = w;
      }
  }
};
struct EpiGateReg {
  unsigned* gp;
  DI void operator()(acc_t& acc, int brow, int bcol) const {
    int e = 0;
#pragma unroll
    for (int m = 0; m < 4; ++m)
#pragma unroll
      for (int n = 0; n < 4; ++n)
#pragma unroll
        for (int j = 0; j < 4; j += 2) { gp[e] = pack2(sigmoidf_(acc[m][n][j]), sigmoidf_(acc[m][n][j + 1])); ++e; }
  }
};
struct EpiMergeReg {
  const unsigned* gp; unsigned* macc;
  DI void operator()(acc_t& acc, int brow, int bcol) const {
    int e = 0;
#pragma unroll
    for (int m = 0; m < 4; ++m)
#pragma unroll
      for (int n = 0; n < 4; ++n)
#pragma unroll
        for (int j = 0; j < 4; j += 2) {
          macc[e] = pack2(lo2f(macc[e]) + lo2f(gp[e]) * acc[m][n][j], hi2f(macc[e]) + hi2f(gp[e]) * acc[m][n][j + 1]);
          ++e;
        }
  }
};

DI void tile_map(int tile, int nM, int nN, int& pm, int& pn) {
  const int WGM = 8;
  int nig = WGM * nN, gid = tile / nig, fm = gid * WGM, gsz = min(nM - fm, WGM);
  pm = fm + ((tile % nig) % gsz); pn = (tile % nig) / gsz;
}

DI int map_col(int mode, int np) {
  if (mode == 0) return np;
  if (mode == 1) { int tile = np >> 7, wc = (np >> 6) & 1, half = (np >> 5) & 1, c = np & 31; return half * DFF + tile * 64 + wc * 32 + c; }
  if (np < 2944) return np;
  if (np < 3968) return np + 32;
  if (np < 4000) return np - 1024;
  if (np < 4096) return -1;
  return np - 96;
}
DI void conv_tile(const float* __restrict__ src, u16* __restrict__ dst, int K, int Nsrc, int mode, int tile) {
  const int tid = tid_();
  extern __shared__ __attribute__((aligned(16))) char smem[];
  float* ts = (float*)smem;
  const int nkt = K / 128;
  const int nt_ = tile / nkt, kt = tile % nkt;
  const int n0 = nt_ * 32, k0 = kt * 128;
  const int ns = map_col(mode, n0);
  __syncthreads();
  {
    int n = tid & 31, k = tid >> 5;
    float v[8];
#pragma unroll
    for (int p = 0; p < 8; ++p) v[p] = (ns >= 0) ? src[(size_t)(k0 + k + 16 * p) * Nsrc + ns + n] : 0.f;
#pragma unroll
    for (int p = 0; p < 8; ++p) ts[(k + 16 * p) * 33 + n] = v[p];
  }
  __syncthreads();
  {
    int n = tid >> 4, kc = (tid & 15) * 8;
    uint4 v;
    v.x = pack2(ts[(kc + 0) * 33 + n], ts[(kc + 1) * 33 + n]);
    v.y = pack2(ts[(kc + 2) * 33 + n], ts[(kc + 3) * 33 + n]);
    v.z = pack2(ts[(kc + 4) * 33 + n], ts[(kc + 5) * 33 + n]);
    v.w = pack2(ts[(kc + 6) * 33 + n], ts[(kc + 7) * 33 + n]);
    *(uint4*)(dst + (size_t)(n0 + n) * K + k0 + kc) = v;
  }
}
DI void phase_convert(CParams& p, int layer) {
  u16* wb = (u16*)(p.ws + B_WB);
  for (int item = blockIdx.x;; item += gridDim.x) {
    int t = item;
    const float* src; u16* dst; int K, Nsrc, Ndst, mode;
#define JOB(SRC, DST, K_, NSRC_, NDST_, MODE_) { int cnt = ((NDST_) / 32) * ((K_) / 128); if (t < cnt) { src = (SRC); dst = (DST); K = (K_); Nsrc = (NSRC_); Ndst = (NDST_); mode = (MODE_); goto found; } t -= cnt; }
    JOB(p.in[2] + (size_t)layer * 1024 * 5632, wb + O_WI1, 1024, 5632, 5632, 1)
    JOB(p.in[3] + (size_t)layer * 2816 * 1024, wb + O_WO1, 2816, 1024, 1024, 0)
    JOB(p.in[5] + (size_t)layer * 1024 * 8096, wb + O_WIN, 1024, 8096, 8192, 2)
    JOB(p.in[11] + (size_t)layer * 384 * 768, wb + O_WQUP, 384, 768, 768, 0)
    JOB(p.in[13] + (size_t)layer * 256 * 1024, wb + O_WKVUP, 256, 1024, 1024, 0)
    JOB(p.in[23] + (size_t)(layer * 4 + 0) * 512 * 1024, wb + O_WBR + (size_t)0 * 1024 * 512, 512, 1024, 1024, 0)
    JOB(p.in[23] + (size_t)(layer * 4 + 1) * 512 * 1024, wb + O_WBR + (size_t)1 * 1024 * 512, 512, 1024, 1024, 0)
    JOB(p.in[23] + (size_t)(layer * 4 + 2) * 512 * 1024, wb + O_WBR + (size_t)2 * 1024 * 512, 512, 1024, 1024, 0)
    JOB(p.in[23] + (size_t)(layer * 4 + 3) * 512 * 1024, wb + O_WBR + (size_t)3 * 1024 * 512, 512, 1024, 1024, 0)
    JOB(p.in[24] + (size_t)layer * 1024 * 1024, wb + O_WOUT, 1024, 1024, 1024, 0)
    JOB(p.in[26] + (size_t)layer * 1024 * 5632, wb + O_WI2, 1024, 5632, 5632, 1)
    JOB(p.in[27] + (size_t)layer * 2816 * 1024, wb + O_WO2, 2816, 1024, 1024, 0)
#undef JOB
    break;
  found:
    (void)Ndst;
    conv_tile(src, dst, K, Nsrc, mode, t);
  }
}

DI void phase_tables(CParams& p) {
  const int tid = tid_();
  float2* gr = (float2*)(p.ws + B_TABG_R); float2* gc = (float2*)(p.ws + B_TABG_C);
  float2* mr = (float2*)(p.ws + B_TABM_R); float2* mc = (float2*)(p.ws + B_TABM_C);
  int gt = blockIdx.x * NTHR + tid, gs = gridDim.x * NTHR;
  for (int i = gt; i < 256 * 16; i += gs) { int pos = i >> 4, f = i & 15; float inv = __builtin_amdgcn_exp2f(-(float)(2 * f) / 32.f * 13.287712379549449f); float a = (float)pos * inv; gr[i] = make_float2(__cosf(a), __sinf(a)); }
  for (int i = gt; i < 64 * 16; i += gs) { int pos = i >> 4, f = i & 15; float inv = __builtin_amdgcn_exp2f(-(float)(2 * f) / 32.f * 13.287712379549449f); float a = (float)pos * inv; gc[i] = make_float2(__cosf(a), __sinf(a)); }
  for (int i = gt; i < 256 * 8; i += gs) { int pos = i >> 3, f = i & 7; float inv = __builtin_amdgcn_exp2f(-(float)(2 * f) / 16.f * 13.287712379549449f); float a = (float)pos * inv; mr[i] = make_float2(__cosf(a), __sinf(a)); }
  for (int i = gt; i < 64 * 8; i += gs) { int pos = i >> 3, f = i & 7; float inv = __builtin_amdgcn_exp2f(-(float)(2 * f) / 16.f * 13.287712379549449f); float a = (float)pos * inv; mc[i] = make_float2(__cosf(a), __sinf(a)); }
}

DI void phase_norm(const float* __restrict__ xsrc, float* __restrict__ xcopy, const float* __restrict__ g, u16* __restrict__ h) {
  const int tid = tid_();
  const int wid = tid >> 6, lane = tid & 63;
  for (int row = blockIdx.x * 8 + wid; row < T_; row += gridDim.x * 8) {
    const float4* xr = (const float4*)(xsrc + (size_t)row * DM);
    float4 v[4]; float ss = 0.f;
#pragma unroll
    for (int i = 0; i < 4; ++i) { v[i] = xr[lane + 64 * i]; ss += v[i].x * v[i].x + v[i].y * v[i].y + v[i].z * v[i].z + v[i].w * v[i].w; }
    ss = wsum_dpp(ss);
    float rs = rsqrtf(ss * (1.f / DM) + 1e-6f);
#pragma unroll
    for (int i = 0; i < 4; ++i) {
      float4 gg = ((const float4*)g)[lane + 64 * i];
      uint2 o = {pack2(v[i].x * rs * gg.x, v[i].y * rs * gg.y), pack2(v[i].z * rs * gg.z, v[i].w * rs * gg.w)};
      *(uint2*)(h + (size_t)row * DM + (lane + 64 * i) * 4) = o;
      if (xcopy) ((float4*)(xcopy + (size_t)row * DM))[lane + 64 * i] = v[i];
    }
  }
}

DI bool tile_map_xcd(int bid, int nblk, int round, int nM, int nN, int& pm, int& pn) {
  if (nblk != 256 || nM != 128 || (nN & 3)) return false;
  const int xcd = bid & 7, loc = bid >> 3, lr = loc & 7, lc = loc >> 3;
  const int ncg = nN >> 2;
  const int cg = round % ncg, rg = round / ncg;
  pm = xcd + 8 * (rg * 8 + lr); pn = cg * 4 + lc;
  return true;
}
template <class Epi>
DI void gemm_phase(const u16* A, int lda, const u16* Bt, int ldb, int K, int M, int N, Epi epi, int first, int stride) {
  const int nM = M / BM, nN = N / BN, ntile = nM * nN;
  int round = 0, pm = 0, pn = 0;
  if (first < ntile) { if (!tile_map_xcd(first, stride, 0, nM, nN, pm, pn)) tile_map(first, nM, nN, pm, pn); }
  for (int tile = first; tile < ntile; tile += stride, ++round) {
    const int nxt = tile + stride;
    const bool hasNext = nxt < ntile;
    int qm = 0, qn = 0;
    if (hasNext) { if (!tile_map_xcd(first, stride, round + 1, nM, nN, qm, qn)) tile_map(nxt, nM, nN, qm, qn); }
    gemm_tile(A, lda, Bt, ldb, K, pm * BM, pn * BN, epi, round > 0, hasNext, qm * BM, qn * BN);
    pm = qm; pn = qn;
  }
}

struct PostTok { u16 rh[10], rq[6], rk[4]; uint4 bg, cg[3], xs[3]; float2 cs; };
DI void post_load(const u16* __restrict__ u, int t, int s, int lane, const float2* tgr, const float2* tgc, PostTok& d) {
  const u16* ur = u + (size_t)t * UW;
  const int rowp = s >> 6, colp = s & 63;
  d.cs = (lane < 32) ? tgr[rowp * 16 + (lane & 15)] : tgc[colp * 16 + (lane & 15)];
#pragma unroll
  for (int hd = 0; hd < 10; ++hd) d.rh[hd] = ur[hd * 64 + lane];
#pragma unroll
  for (int k = 0; k < 6; ++k) d.rq[k] = ur[UQLAT + lane + 64 * k];
#pragma unroll
  for (int k = 0; k < 4; ++k) d.rk[k] = ur[UKVLAT + lane + 64 * k];
  const int c0 = lane * 8;
  d.bg = *(const uint4*)(ur + USC + c0);
#pragma unroll
  for (int k = 0; k < 3; ++k) {
    const int s2 = s + k - 1;
    if (s2 >= 0 && s2 < S_) {
      const u16* r2 = u + (size_t)(t + k - 1) * UW + USC;
      d.cg[k] = *(const uint4*)(r2 + 512 + c0); d.xs[k] = *(const uint4*)(r2 + 1024 + c0);
    } else { d.cg[k] = uint4{0, 0, 0, 0}; d.xs[k] = uint4{0, 0, 0, 0}; }
  }
}
DI void post_tile(CParams& p, int layer, int tile) {
  const int tid = tid_();
  extern __shared__ __attribute__((aligned(16))) char smem[];
  u16* u = (u16*)(p.ws + B_U);
  const float2* tgr = (const float2*)(p.ws + B_TABG_R); const float2* tgc = (const float2*)(p.ws + B_TABG_C);
  const int wid = tid >> 6, lane = tid & 63;
  const int tb = tile * 64;
  const int b = tb / S_, sb = tb % S_;
  const float* qn = p.in[6] + layer * 64; const float* kn = p.in[7] + layer * 64;
  const float* scw = p.in[8] + layer * 3 * 512; const float* scb = p.in[9] + layer * 512;
  const float* qan = p.in[10] + layer * 384; const float* kvan = p.in[12] + layer * 256;
  const float gq = qn[lane], gk = kn[lane];
  float qanr[6], kvanr[4], scwr[3][8], scbr[8];
#pragma unroll
  for (int k = 0; k < 6; ++k) qanr[k] = qan[lane + 64 * k];
#pragma unroll
  for (int k = 0; k < 4; ++k) kvanr[k] = kvan[lane + 64 * k];
#pragma unroll
  for (int e = 0; e < 8; ++e) { scbr[e] = scb[lane * 8 + e];
#pragma unroll
    for (int k = 0; k < 3; ++k) scwr[k][e] = scw[k * 512 + lane * 8 + e]; }
  __syncthreads();
  PostTok dA, dB;
  post_load(u, tb + wid * 8, sb + wid * 8, lane, tgr, tgc, dA);
#pragma unroll
  for (int i = 0; i < 8; ++i) {
    PostTok& d = (i & 1) ? dB : dA;
    PostTok& dn = (i & 1) ? dA : dB;
    const int tl = wid * 8 + i, t = tb + tl, s = sb + tl;
    if (i + 1 < 8) post_load(u, t + 1, s + 1, lane, tgr, tgc, dn);
    u16* ur = u + (size_t)t * UW;
    const float2 cs = d.cs;
    float xh[10], ss[12];
#pragma unroll
    for (int hd = 0; hd < 10; ++hd) { xh[hd] = bf2f(d.rh[hd]); ss[hd] = xh[hd] * xh[hd]; }
    float xq[6], xk[4];
    ss[10] = 0.f; ss[11] = 0.f;
#pragma unroll
    for (int k = 0; k < 6; ++k) { xq[k] = bf2f(d.rq[k]); ss[10] += xq[k] * xq[k]; }
#pragma unroll
    for (int k = 0; k < 4; ++k) { xk[k] = bf2f(d.rk[k]); ss[11] += xk[k] * xk[k]; }
#pragma unroll
    for (int c = 0; c < 12; ++c) ss[c] = wsum_dpp(ss[c]);
    float yh[10], prh[10];
#pragma unroll
    for (int hd = 0; hd < 10; ++hd) yh[hd] = xh[hd] * rsqrtf(ss[hd] * (1.f / 64.f) + 1e-6f) * (hd < 8 ? gq : gk);
#pragma unroll
    for (int hd = 0; hd < 10; ++hd) prh[hd] = xor16_(yh[hd], lane);
#pragma unroll
    for (int hd = 0; hd < 10; ++hd) {
      float o = yh[hd] * cs.x + ((lane & 16) ? prh[hd] : -prh[hd]) * cs.y;
      if (hd < 8) o *= 0.125f * 1.4426950408889634f;
      ur[hd * 64 + lane] = f2bf(o);
    }
    {
      float rs = rsqrtf(ss[10] * (1.f / 384.f) + 1e-6f);
#pragma unroll
      for (int k = 0; k < 6; ++k) ur[UQLAT + lane + 64 * k] = f2bf(xq[k] * rs * qanr[k]);
      float rs2 = rsqrtf(ss[11] * (1.f / 256.f) + 1e-6f);
#pragma unroll
      for (int k = 0; k < 4; ++k) ur[UKVLAT + lane + 64 * k] = f2bf(xk[k] * rs2 * kvanr[k]);
    }
    {
      const int c0 = lane * 8;
      float accv[8];
#pragma unroll
      for (int e = 0; e < 8; ++e) accv[e] = scbr[e];
#pragma unroll
      for (int k = 0; k < 3; ++k) {
        const unsigned cgs[4] = {d.cg[k].x, d.cg[k].y, d.cg[k].z, d.cg[k].w}; const unsigned xss[4] = {d.xs[k].x, d.xs[k].y, d.xs[k].z, d.xs[k].w};
#pragma unroll
        for (int e = 0; e < 4; ++e) {
          accv[2 * e] += scwr[k][2 * e] * (lo2f(cgs[e]) * lo2f(xss[e]));
          accv[2 * e + 1] += scwr[k][2 * e + 1] * (hi2f(cgs[e]) * hi2f(xss[e]));
        }
      }
      const uint4 bg = d.bg;
      uint4 o;
      o.x = pack2(lo2f(bg.x) * accv[0], hi2f(bg.x) * accv[1]);
      o.y = pack2(lo2f(bg.y) * accv[2], hi2f(bg.y) * accv[3]);
      o.z = pack2(lo2f(bg.z) * accv[4], hi2f(bg.z) * accv[5]);
      o.w = pack2(lo2f(bg.w) * accv[6], hi2f(bg.w) * accv[7]);
      *(uint4*)(ur + USC + c0) = o;
    }
  }
  {
    u16* ls = (u16*)smem;
    int tok = tid >> 3, ch = tid & 7;
    const u16* src = u + (size_t)(tb + tok) * UW + UV + ch * 16;
    uint4 a = *(const uint4*)src, c = *(const uint4*)(src + 8);
    const unsigned w[8] = {a.x, a.y, a.z, a.w, c.x, c.y, c.z, c.w};
    int pt = permkey(tok);
#pragma unroll
    for (int e = 0; e < 8; ++e) {
      ls[(ch * 16 + 2 * e) * 72 + pt] = (u16)(w[e] & 0xffff);
      ls[(ch * 16 + 2 * e + 1) * 72 + pt] = (u16)(w[e] >> 16);
    }
    __syncthreads();
    u16* vtg = (u16*)(p.ws + B_VTG);
#pragma unroll
    for (int k = 0; k < 2; ++k) {
      int idx = tid + 512 * k, row = idx >> 3, c8 = idx & 7;
      uint4 v = *(const uint4*)(ls + row * 72 + c8 * 8);
      *(uint4*)(vtg + ((size_t)(b * 2 + (row >> 6)) * 64 + (row & 63)) * S_ + sb + c8 * 8) = v;
    }
  }
}

DI void lru_phase(CParams& p, int layer, int pass, int bid, int nblk, unsigned* qctr = nullptr, volatile unsigned __attribute__((address_space(3)))* qslot = nullptr) {
  const int tid = tid_();
  extern __shared__ __attribute__((aligned(16))) char smem[];
  u16* xcb = (u16*)smem;
  float* xcf = (float*)(smem + 64 * 72 * 2);
  float* G = xcf + 64 * 64;
  float2* part = (float2*)(G + 4 * 64 * 64);
  u16* u = (u16*)(p.ws + B_U);
  const float* cw = p.in[16] + layer * 4 * 512; const float* cb = p.in[17] + layer * 512;
  const float* lam = p.in[22] + (size_t)layer * 2 * 512;
  const int wid = tid >> 6, lane = tid & 63;
  const int mi = wid >> 1, dh = wid & 1, r = lane & 31, hh = lane >> 5, mdir = mi >> 1;
  const int ctok = tid >> 3, ccg = (tid & 7) * 8;
  const int ec = tid & 63;
  const int sdir = tid >> 8, ssub = (tid >> 6) & 3;
  int nbPrev = -1;
  bf16x8 wf[4]; float bs = 0.f, sp0 = 0.f, sp1 = 0.f;
  float cwr[4][8], cbr[8];
  const int qcls = (bid >> 3) & 7;
#pragma unroll 1
  for (int item = bid;; item += nblk) {
    if (qctr) {
      if (tid == 0) *qslot = atomicAdd(qctr + qcls, 1u);
      __syncthreads();
      const unsigned tk = *qslot;
      if (tk >= 512u) break;
      item = (int)tk * 8 + qcls;
    } else if (item >= 4096) break;
    const int nb = item & 7, j = (item >> 3) & 255, b = item >> 11;
    const int c0 = nb * 64, s0 = j * 64;
    if (nb != nbPrev) {
      nbPrev = nb;
      const float* W = ((mi & 1) ? p.in[20] : p.in[18]) + ((size_t)((layer * 2 + mdir) * 8 + nb)) * 64 * 64;
      const float* bias = ((mi & 1) ? p.in[21] : p.in[19]) + (size_t)(layer * 2 + mdir) * 512 + c0;
#pragma unroll
      for (int ks = 0; ks < 4; ++ks) {
        unsigned bw[4];
#pragma unroll
        for (int jj = 0; jj < 4; ++jj) {
          float w0 = W[(16 * ks + 8 * hh + 2 * jj) * 64 + 32 * dh + r];
          float w1 = W[(16 * ks + 8 * hh + 2 * jj + 1) * 64 + 32 * dh + r];
          bw[jj] = pack2(w0, w1);
        }
        uint4 bq = {bw[0], bw[1], bw[2], bw[3]};
        wf[ks] = __builtin_bit_cast(bf16x8, bq);
      }
      bs = bias[32 * dh + r];
      sp0 = softplus_neg(lam[c0 + ec]); sp1 = softplus_neg(lam[512 + c0 + ec]);
#pragma unroll
      for (int e = 0; e < 8; ++e) {
        cbr[e] = cb[c0 + ccg + e];
#pragma unroll
        for (int k = 0; k < 4; ++k) cwr[k][e] = cw[k * 512 + c0 + ccg + e];
      }
    }
    __syncthreads();
    {
      float a[8];
#pragma unroll
      for (int e = 0; e < 8; ++e) a[e] = cbr[e];
#pragma unroll
      for (int k = 0; k < 4; ++k) {
        int s2 = s0 + ctok + k - 2;
        if (s2 >= 0 && s2 < S_) {
          uint4 xv = *(const uint4*)(u + (size_t)(b * S_ + s2) * UW + ULRU + 512 + c0 + ccg);
          const unsigned w[4] = {xv.x, xv.y, xv.z, xv.w};
#pragma unroll
          for (int e = 0; e < 4; ++e) {
            a[2 * e] += cwr[k][2 * e] * lo2f(w[e]);
            a[2 * e + 1] += cwr[k][2 * e + 1] * hi2f(w[e]);
          }
        }
      }
#pragma unroll
      for (int e = 0; e < 8; ++e) xcf[ctok * 64 + ccg + e] = a[e];
      uint4 o = {pack2(a[0], a[1]), pack2(a[2], a[3]), pack2(a[4], a[5]), pack2(a[6], a[7])};
      *(uint4*)(xcb + ctok * 72 + ccg) = o;
    }
    u16* gp = u + (size_t)(b * S_ + s0 + ctok) * UW + ULRU + c0 + ccg;
    uint4 gv = {0, 0, 0, 0};
    if (pass == 3) gv = *(const uint4*)gp;
    __syncthreads();
    {
      f32x16 acc0, acc1;
#pragma unroll
      for (int i = 0; i < 16; ++i) { acc0[i] = 0.f; acc1[i] = 0.f; }
#pragma unroll
      for (int ks = 0; ks < 4; ++ks) {
        bf16x8 a0 = *(const bf16x8*)(xcb + (r)*72 + 16 * ks + 8 * hh);
        bf16x8 a1 = *(const bf16x8*)(xcb + (32 + r) * 72 + 16 * ks + 8 * hh);
        acc0 = __builtin_amdgcn_mfma_f32_32x32x16_bf16(a0, wf[ks], acc0, 0, 0, 0);
        acc1 = __builtin_amdgcn_mfma_f32_32x32x16_bf16(a1, wf[ks], acc1, 0, 0, 0);
      }
#pragma unroll
      for (int i = 0; i < 16; ++i) {
        int row = (i & 3) + 8 * (i >> 2) + 4 * hh;
        G[(mi * 64 + row) * 64 + 32 * dh + r] = sigmoidf_(acc0[i] + bs);
        G[(mi * 64 + 32 + row) * 64 + 32 * dh + r] = sigmoidf_(acc1[i] + bs);
      }
    }
    __syncthreads();
    {
      const float* Ga = G + (2 * sdir) * 4096; float* Gb = G + (2 * sdir + 1) * 4096;
      const int tb = ssub * 16;
      const float sp = sdir ? sp1 : sp0;
      float av[16], bv[16];
#pragma unroll
      for (int k = 0; k < 16; ++k) {
        const int t = tb + (sdir ? 15 - k : k);
        const float rr = Ga[t * 64 + ec], ii = Gb[t * 64 + ec];
        const float la = -8.f * rr * sp;
        av[k] = __expf(la);
        bv[k] = __builtin_amdgcn_sqrtf(one_minus_exp(2.f * la)) * ii * xcf[t * 64 + ec];
      }
      float hv = 0.f, P = 1.f;
#pragma unroll
      for (int k = 0; k < 16; ++k) { hv = av[k] * hv + bv[k]; P *= av[k]; }
      part[(sdir * 4 + ssub) * 64 + ec] = make_float2(P, hv);
      __syncthreads();
      const size_t sidx = ((size_t)((b * 2 + sdir) * 256 + j)) * 512 + c0 + ec;
      if (pass == 1) {
        if (ssub == 0) {
          float Pt = 1.f, ht = 0.f;
#pragma unroll
          for (int q = 0; q < 4; ++q) { float2 pq = part[(sdir * 4 + (sdir ? 3 - q : q)) * 64 + ec]; ht = pq.x * ht + pq.y; Pt *= pq.x; }
          ((float2*)(p.ws + B_SUMM))[sidx] = make_float2(Pt, ht);
        }
      } else {
        float cin = ((const float*)(p.ws + B_CARRY))[sidx];
#pragma unroll
        for (int q = 0; q < 3; ++q) {
          const int sq = sdir ? 3 - q : q;
          const bool before = sdir ? (sq > ssub) : (sq < ssub);
          float2 pq = part[(sdir * 4 + sq) * 64 + ec];
          if (before) cin = pq.x * cin + pq.y;
        }
        hv = cin;
#pragma unroll
        for (int k = 0; k < 16; ++k) { const int t = tb + (sdir ? 15 - k : k); hv = av[k] * hv + bv[k]; Gb[t * 64 + ec] = hv; }
      }
    }
    if (pass == 3) {
      __syncthreads();
      const unsigned w[4] = {gv.x, gv.y, gv.z, gv.w};
      float o[8];
#pragma unroll
      for (int e = 0; e < 8; ++e) {
        float g = (e & 1) ? hi2f(w[e >> 1]) : lo2f(w[e >> 1]);
        float ge = 0.5f * g * (1.f + tanh_(0.7978845608028654f * (g + 0.044715f * g * g * g)));
        o[e] = ge * (G[(1 * 64 + ctok) * 64 + ccg + e] + G[(3 * 64 + ctok) * 64 + ccg + e]);
      }
      uint4 ov = {pack2(o[0], o[1]), pack2(o[2], o[3]), pack2(o[4], o[5]), pack2(o[6], o[7])};
      *(uint4*)gp = ov;
    }
  }
}
DI void lru_carry(CParams& p, int blk) {
  const int tid = tid_();
  int id = blk * NTHR + tid;
  int c = id & 511, dir = (id >> 9) & 1, b = id >> 10;
  const float2* __restrict__ sm = (const float2*)(p.ws + B_SUMM) + (size_t)(b * 2 + dir) * 256 * 512 + c;
  float* __restrict__ cr = (float*)(p.ws + B_CARRY) + (size_t)(b * 2 + dir) * 256 * 512 + c;
  float cin = 0.f;
#pragma unroll 1
  for (int k0 = 0; k0 < 256; k0 += 32) {
    float2 ab[32];
#pragma unroll
    for (int i = 0; i < 32; ++i) { const int j = dir ? 255 - (k0 + i) : (k0 + i); ab[i] = sm[(size_t)j * 512]; }
#pragma unroll
    for (int i = 0; i < 32; ++i) {
      const int j = dir ? 255 - (k0 + i) : (k0 + i);
      cr[(size_t)j * 512] = cin;
      cin = ab[i].x * cin + ab[i].y;
    }
  }
}

template <int D>
DI void attn_tile(const u16* __restrict__ Qp, int ldq, const u16* __restrict__ Kp, int ldk, const u16* __restrict__ Vt,
                  u16* __restrict__ Op, int ldo, int q0, float cs, float mc) {
  const int tid = tid_();
  extern __shared__ __attribute__((aligned(16))) char smem[];
  constexpr int KS = D * 2 + 16, VS = 144, KB = 64 * KS, VB = 64 * VS, BUF = KB + VB;
  constexpr int NKS = D / 16, CPR = D / 8;
  constexpr int NIT = S_ / 64;
  const int wid = tid >> 6, lane = tid & 63, r = lane & 31, hh = lane >> 5, grp = wid >> 2;
  __syncthreads();
  bf16x8 qf[NKS];
  {
    const u16* qr = Qp + (size_t)(q0 + wid * 32 + r) * ldq + 8 * hh;
#pragma unroll
    for (int ks = 0; ks < NKS; ++ks) qf[ks] = *(const bf16x8*)(qr + 16 * ks);
  }
  f32x16 o0, o1, s0, s1;
#pragma unroll
  for (int i = 0; i < 16; ++i) { o0[i] = 0.f; o1[i] = 0.f; }
  float lsum0 = 0.f, lsum1 = 0.f;
  uint4 kr0, kr1, vr;
  const int vrow = tid >> 3, vch = tid & 7;
  int krow0, kch0, krow1 = 0, kch1 = 0;
  if (D == 64) { krow0 = tid >> 3; kch0 = tid & 7; }
  else { krow0 = tid / CPR; kch0 = tid % CPR; int i2 = tid + 512; krow1 = i2 / CPR; kch1 = i2 % CPR; }
  const bool k2 = (D == 96) && (tid < 256);
  kr1 = uint4{0, 0, 0, 0};
#define LOADT(key0) do { kr0 = *(const uint4*)(Kp + (size_t)((key0) + krow0) * ldk + kch0 * 8); \
    if (k2) kr1 = *(const uint4*)(Kp + (size_t)((key0) + krow1) * ldk + kch1 * 8); \
    vr = *(const uint4*)(Vt + (size_t)vrow * S_ + (key0) + vch * 8); } while (0)
#define STORET(bufi) do { char* bb = smem + (bufi) * BUF; *(uint4*)(bb + krow0 * KS + kch0 * 16) = kr0; \
    if (k2) *(uint4*)(bb + krow1 * KS + kch1 * 16) = kr1; \
    *(uint4*)(bb + KB + vrow * VS + vch * 16) = vr; } while (0)
#define LOADKF(bufi) do { const char* kb_ = smem + (bufi) * BUF + r * KS + 16 * hh; \
    _Pragma("unroll") for (int ks = 0; ks < NKS; ++ks) { kf0[ks] = *(const bf16x8*)(kb_ + 32 * ks); kf1[ks] = *(const bf16x8*)(kb_ + 32 * KS + 32 * ks); } } while (0)
#define SMMA() do { const f32x16 z_ = {0.f, 0.f, 0.f, 0.f, 0.f, 0.f, 0.f, 0.f, 0.f, 0.f, 0.f, 0.f, 0.f, 0.f, 0.f, 0.f}; \
    s0 = __builtin_amdgcn_mfma_f32_32x32x16_bf16(kf0[0], qf[0], z_, 0, 0, 0); \
    s1 = __builtin_amdgcn_mfma_f32_32x32x16_bf16(kf1[0], qf[0], z_, 0, 0, 0); \
    _Pragma("unroll") for (int ks = 1; ks < NKS; ++ks) { s0 = __builtin_amdgcn_mfma_f32_32x32x16_bf16(kf0[ks], qf[ks], s0, 0, 0, 0); \
      s1 = __builtin_amdgcn_mfma_f32_32x32x16_bf16(kf1[ks], qf[ks], s1, 0, 0, 0); } } while (0)
#define BARX do { __builtin_amdgcn_sched_barrier(0); asm volatile("s_waitcnt lgkmcnt(0)" ::: "memory"); __builtin_amdgcn_s_barrier(); __builtin_amdgcn_sched_barrier(0); } while (0)
  bf16x8 kf0[NKS], kf1[NKS];
  LOADT(0); STORET(0);
  LOADT(64); STORET(1);
  __syncthreads();
  LOADT(128);
  LOADKF(0);
  SMMA();
  if (grp == 1) BARX;
#pragma unroll 1
  for (int it = 0; it < NIT; ++it) {
    bf16x8 pf[2][2];
    if (mc != 0.f) {
#pragma unroll
      for (int i = 0; i < 16; ++i) { s0[i] -= mc; s1[i] -= mc; }
    }
#pragma unroll
    for (int i = 0; i < 16; ++i) {
      s0[i] = __builtin_amdgcn_exp2f(s0[i]); s1[i] = __builtin_amdgcn_exp2f(s1[i]);
      lsum0 += s0[i]; lsum1 += s1[i];
    }
#pragma unroll
    for (int st = 0; st < 2; ++st) {
      uint4 a = {pack2(s0[8 * st], s0[8 * st + 1]), pack2(s0[8 * st + 2], s0[8 * st + 3]), pack2(s0[8 * st + 4], s0[8 * st + 5]), pack2(s0[8 * st + 6], s0[8 * st + 7])};
      uint4 c = {pack2(s1[8 * st], s1[8 * st + 1]), pack2(s1[8 * st + 2], s1[8 * st + 3]), pack2(s1[8 * st + 4], s1[8 * st + 5]), pack2(s1[8 * st + 6], s1[8 * st + 7])};
      pf[0][st] = __builtin_bit_cast(bf16x8, a); pf[1][st] = __builtin_bit_cast(bf16x8, c);
    }
    if (it + 2 < NIT) STORET((it + 2) & 3);
    if (it + 3 < NIT) LOADT((it + 3) * 64);
    if (it + 1 < NIT) LOADKF((it + 1) & 3);
    BARX;
    __builtin_amdgcn_s_setprio(1);
    {
      const char* vb = smem + (it & 3) * BUF + KB + r * VS + 16 * hh;
      bf16x8 v0[2], v1[2];
#pragma unroll
      for (int q = 0; q < 2; ++q) { v0[q] = *(const bf16x8*)(vb + 32 * q); v1[q] = *(const bf16x8*)(vb + 32 * VS + 32 * q); }
      if (it + 1 < NIT) SMMA();
#pragma unroll
      for (int q = 0; q < 2; ++q) {
        o0 = __builtin_amdgcn_mfma_f32_32x32x16_bf16(v0[q], pf[0][q], o0, 0, 0, 0);
        o1 = __builtin_amdgcn_mfma_f32_32x32x16_bf16(v1[q], pf[0][q], o1, 0, 0, 0);
      }
#pragma unroll
      for (int q = 0; q < 2; ++q) { v0[q] = *(const bf16x8*)(vb + 64 + 32 * q); v1[q] = *(const bf16x8*)(vb + 32 * VS + 64 + 32 * q); }
#pragma unroll
      for (int q = 0; q < 2; ++q) {
        o0 = __builtin_amdgcn_mfma_f32_32x32x16_bf16(v0[q], pf[1][q], o0, 0, 0, 0);
        o1 = __builtin_amdgcn_mfma_f32_32x32x16_bf16(v1[q], pf[1][q], o1, 0, 0, 0);
      }
    }
    __builtin_amdgcn_s_setprio(0);
    BARX;
  }
  if (grp == 0) BARX;
#undef LOADT
#undef STORET
#undef LOADKF
#undef SMMA
#undef BARX
  float lsum = lsum0 + lsum1;
  lsum += shx(lsum, 32, lane);
  const float inv = rcp_(lsum);
  u16* orow = Op + (size_t)(q0 + wid * 32 + r) * ldo;
#pragma unroll
  for (int g = 0; g < 4; ++g) {
    uint2 a = {pack2(o0[4 * g] * inv, o0[4 * g + 1] * inv), pack2(o0[4 * g + 2] * inv, o0[4 * g + 3] * inv)};
    uint2 c = {pack2(o1[4 * g] * inv, o1[4 * g + 1] * inv), pack2(o1[4 * g + 2] * inv, o1[4 * g + 3] * inv)};
    *(uint2*)(orow + 8 * g + 4 * hh) = a;
    *(uint2*)(orow + 32 + 8 * g + 4 * hh) = c;
  }
}

DI float gain_absmax(const float* g, int n) {
  float m = 0.f;
  for (int i = 0; i < n; ++i) m = fmaxf(m, fabsf(g[i]));
  return m;
}

struct MlaTok { unsigned qw[8], kw[8]; float2 c0, c1; };
DI void mla_load(const u16* __restrict__ u, const u16* __restrict__ qm, const u16* __restrict__ kvm, int t, int s, int lane, int e0, bool rl,
                 const float2* tmr, const float2* tmc, MlaTok& d) {
  const int rowp = s >> 6, colp = s & 63;
  d.c0 = float2{1.f, 0.f}; d.c1 = float2{1.f, 0.f};
  if (rl) {
    if (e0 < 16) { d.c0 = tmr[rowp * 8 + (e0 & 7)]; d.c1 = tmr[rowp * 8 + ((e0 + 1) & 7)]; }
    else { d.c0 = tmc[colp * 8 + (e0 & 7)]; d.c1 = tmc[colp * 8 + ((e0 + 1) & 7)]; }
  }
  const unsigned kro = rl ? *(const unsigned*)(u + (size_t)t * UW + UKROPE + e0) : 0u;
#pragma unroll
  for (int hd = 0; hd < 8; ++hd) {
    d.qw[hd] = (lane < 48) ? *(const unsigned*)(qm + (size_t)t * 768 + hd * 96 + 2 * lane) : 0u;
    d.kw[hd] = (lane < 32) ? *(const unsigned*)(kvm + (size_t)t * 1024 + hd * 128 + 2 * lane) : kro;
  }
}
DI void mla_post_tile(CParams& p, int layer, int tile) {
  const int tid = tid_();
  extern __shared__ __attribute__((aligned(16))) char smem[];
  u16* ls = (u16*)smem;
  u16* u = (u16*)(p.ws + B_U); u16* qm = (u16*)(p.ws + B_QM); u16* kvm = (u16*)(p.ws + B_KVM); u16* vtm = (u16*)(p.ws + B_VTM);
  const float2* tmr = (const float2*)(p.ws + B_TABM_R); const float2* tmc = (const float2*)(p.ws + B_TABM_C);
  const float* qn = p.in[14] + layer * 96; const float* kn = p.in[15] + layer * 96;
  const int wid = tid >> 6, lane = tid & 63;
  const int tb = tile * 64, b = tb / S_, sb = tb % S_;
  __syncthreads();
#pragma unroll
  for (int k = 0; k < 8; ++k) {
    int idx = tid + 512 * k, tok = idx >> 6, cc = idx & 63, hd = cc >> 3, dvc = (cc & 7) * 8;
    uint4 v = *(const uint4*)(kvm + (size_t)(tb + tok) * 1024 + hd * 128 + 64 + dvc);
    const unsigned w[4] = {v.x, v.y, v.z, v.w};
    int pt = permkey(tok);
#pragma unroll
    for (int e = 0; e < 4; ++e) {
      ls[(hd * 64 + dvc + 2 * e) * 72 + pt] = (u16)(w[e] & 0xffff);
      ls[(hd * 64 + dvc + 2 * e + 1) * 72 + pt] = (u16)(w[e] >> 16);
    }
  }
  __syncthreads();
  const int e0 = 2 * (lane - 32);
  const bool rl = lane >= 32 && lane < 48;
  float gq0 = 0.f, gq1 = 0.f, gk0 = 0.f, gk1 = 0.f;
  if (lane < 48) { gq0 = qn[2 * lane]; gq1 = qn[2 * lane + 1]; gk0 = kn[2 * lane]; gk1 = kn[2 * lane + 1]; }
  MlaTok mA, mB;
  mla_load(u, qm, kvm, tb + wid * 8, sb + wid * 8, lane, e0, rl, tmr, tmc, mA);
#pragma unroll
  for (int i = 0; i < 8; ++i) {
    MlaTok& d = (i & 1) ? mB : mA;
    MlaTok& dn = (i & 1) ? mA : mB;
    const int tl = wid * 8 + i, t = tb + tl;
    if (i + 1 < 8) mla_load(u, qm, kvm, t + 1, sb + tl + 1, lane, e0, rl, tmr, tmc, dn);
    const float2 c0 = d.c0, c1 = d.c1;
    float ss[16];
#pragma unroll
    for (int hd = 0; hd < 8; ++hd) {
      float a0 = lo2f(d.qw[hd]), a1 = hi2f(d.qw[hd]), b0 = lo2f(d.kw[hd]), b1 = hi2f(d.kw[hd]);
      ss[hd] = a0 * a0 + a1 * a1; ss[8 + hd] = b0 * b0 + b1 * b1;
    }
#pragma unroll
    for (int c = 0; c < 16; ++c) ss[c] = wsum_dpp(ss[c]);
    const float qsc = (1.f / 9.797958971132712f) * 1.4426950408889634f;
    const bool up = (e0 & 8) != 0;
#pragma unroll
    for (int hd = 0; hd < 8; ++hd) {
      {
        float rs = rsqrtf(ss[hd] * (1.f / 96.f) + 1e-6f);
        float y0 = lo2f(d.qw[hd]) * rs * gq0, y1 = hi2f(d.qw[hd]) * rs * gq1;
        float p0 = xor4_(y0), p1 = xor4_(y1);
        if (rl) { y0 = y0 * c0.x + (up ? p0 : -p0) * c0.y; y1 = y1 * c1.x + (up ? p1 : -p1) * c1.y; }
        if (lane < 48) *(unsigned*)(qm + (size_t)t * 768 + hd * 96 + 2 * lane) = pack2(y0 * qsc, y1 * qsc);
      }
      {
        float rs = rsqrtf(ss[8 + hd] * (1.f / 96.f) + 1e-6f);
        float y0 = lo2f(d.kw[hd]) * rs * gk0, y1 = hi2f(d.kw[hd]) * rs * gk1;
        float p0 = xor4_(y0), p1 = xor4_(y1);
        if (rl) { y0 = y0 * c0.x + (up ? p0 : -p0) * c0.y; y1 = y1 * c1.x + (up ? p1 : -p1) * c1.y; }
        if (lane < 48) *(unsigned*)(kvm + (size_t)t * 1024 + hd * 128 + 2 * lane) = pack2(y0, y1);
      }
    }
  }
#pragma unroll
  for (int k = 0; k < 8; ++k) {
    int idx = tid + 512 * k, row = idx >> 3, c8 = idx & 7;
    uint4 v = *(const uint4*)(ls + row * 72 + c8 * 8);
    *(uint4*)(vtm + ((size_t)(b * 8 + (row >> 6)) * 64 + (row & 63)) * S_ + sb + c8 * 8) = v;
  }
}


#define XB_TMO      128
#define XB_XCNT(j)  (256  + 64 * (j))
#define XB_XSUB(j)  (1280 + 64 * (j))
#define XB_XGEN(j)  (2304 + 64 * (j))
#define XB_TOP      3328
#define XB_TOPGEN   3392
#define XB_SPIN_CAP (1u << 24)
#define LAS __attribute__((address_space(3)))
DI unsigned xb_ld(unsigned* p) { return __hip_atomic_load(p, __ATOMIC_RELAXED, __HIP_MEMORY_SCOPE_AGENT); }
DI unsigned xb_add(unsigned* p, unsigned v) { return __hip_atomic_fetch_add(p, v, __ATOMIC_RELAXED, __HIP_MEMORY_SCOPE_AGENT); }
DI unsigned xb_xcc_id() { return (unsigned)__builtin_amdgcn_s_getreg((3 << 11) | 20) & 0xFu; }
#define XB_SPIN(cond, bar) do { unsigned _sp = 0; while (cond) { __builtin_amdgcn_s_sleep(1); \
    if ((++_sp & 255u) == 0u) { if (xb_ld(&(bar)[XB_TMO])) break; if (_sp > XB_SPIN_CAP) { atomicAdd(&(bar)[XB_TMO], 1u); break; } } } } while (0)
struct XcdBarrier { unsigned* bar; unsigned x; volatile LAS unsigned* st; };
DI XcdBarrier xcd_barrier_post(unsigned* bar, volatile LAS unsigned* st) {
  XcdBarrier b; b.bar = bar; b.x = xb_xcc_id(); b.st = st;
  if (threadIdx.x == 0) (void)xb_add(&bar[XB_XCNT(b.x)], 1u);
  return b;
}
DI void xcd_barrier_complete(unsigned* bar, unsigned x, unsigned& nloc, unsigned& nx) {
  const unsigned G = gridDim.x * gridDim.y * gridDim.z;
  unsigned sum, cnt, mine, sp = 0u;
  for (;;) {
    sum = 0u; cnt = 0u; mine = 0u;
#pragma unroll
    for (unsigned j = 0; j < 16; ++j) { const unsigned c = xb_ld(&bar[XB_XCNT(j)]); sum += c; cnt += (c > 0u) ? 1u : 0u; mine = (j == x) ? c : mine; }
    if (sum == G) break;
    __builtin_amdgcn_s_sleep(1);
    if ((++sp & 255u) == 0u) { if (xb_ld(&bar[XB_TMO])) break; if (sp > XB_SPIN_CAP) { atomicAdd(&bar[XB_TMO], 1u); break; } }
  }
  nloc = mine > 0u ? mine : 1u; nx = cnt > 0u ? cnt : 1u;
}
DI void xcd_barrier(const XcdBarrier& b) {
  asm volatile("s_waitcnt vmcnt(0)" ::: "memory");
  __syncthreads();
  if (threadIdx.x == 0) {
    unsigned* bar = b.bar;
    __builtin_amdgcn_s_waitcnt(0);
    unsigned nloc = b.st[0], nx = b.st[1];
    if (nloc == 0u) { xcd_barrier_complete(bar, b.x, nloc, nx); b.st[0] = nloc; b.st[1] = nx; }
    const unsigned old = xb_add(&bar[XB_XSUB(b.x)], 1u);
    const unsigned gen = old / nloc;
    if (old + 1u == (gen + 1u) * nloc) {
      __builtin_amdgcn_fence(__ATOMIC_RELEASE, "agent");
      asm volatile("s_waitcnt vmcnt(0)" ::: "memory");
      const unsigned og = xb_add(&bar[XB_TOP], 1u);
      const unsigned tg = og / nx;
      if (og + 1u == (tg + 1u) * nx) xb_add(&bar[XB_TOPGEN], 1u);
      else XB_SPIN(xb_ld(&bar[XB_TOPGEN]) == tg, bar);
      __builtin_amdgcn_fence(__ATOMIC_ACQUIRE, "agent");
      xb_add(&bar[XB_XGEN(b.x)], 1u);
      asm volatile("s_waitcnt vmcnt(0)" ::: "memory");
    } else {
      XB_SPIN(xb_ld(&bar[XB_XGEN(b.x)]) == gen, bar);
      __builtin_amdgcn_fence(__ATOMIC_ACQUIRE, "agent");
      asm volatile("s_waitcnt vmcnt(0)" ::: "memory");
    }
  }
  __syncthreads();
}

__global__ void __launch_bounds__(NTHR) fwd_megakernel(Params p_unused) {
  cg::grid_group grid = cg::this_grid();
  __shared__ uint4 xb_words;
  if (threadIdx.x == 0) xb_words = make_uint4(0u, 0u, 0u, 0u);
  __syncthreads();
  XcdBarrier xb = xcd_barrier_post((unsigned*)(((CParams*)__builtin_amdgcn_kernarg_segment_ptr())->ws + B_BAR), (volatile LAS unsigned*)&xb_words);
  grid.sync();
  const float LOG2E = 1.4426950408889634f;
  constexpr int NPH = 14;
#pragma unroll 1
  for (int step = 0; step < NL * NPH; ++step) {
    int layer = step / NPH; const int ph = step % NPH;
    asm volatile("" : "+s"(layer));
    int bid = blockIdx.x, nblk = gridDim.x;
    asm volatile("" : "+s"(bid)); asm volatile("" : "+s"(nblk));
    CParams* pp = (CParams*)__builtin_amdgcn_kernarg_segment_ptr();
    asm volatile("" : "+s"(pp));
    CParams& p = *pp;
    u16* wb = (u16*)(p.ws + B_WB);
    u16* h = (u16*)(p.ws + B_H);
    u16* u = (u16*)(p.ws + B_U);
    float* x = p.out;
    switch (ph) {
      case 0: {
        if (layer == 0) phase_tables(p);
        phase_convert(p, layer);
        phase_norm(layer == 0 ? p.in[0] : x, layer == 0 ? x : nullptr, p.in[1] + layer * DM, h);
      } break;
      case 1: gemm_phase(h, DM, wb + O_WI1, DM, DM, T_, 2 * DFF, EpiSwiglu{u}, bid, nblk); break;
      case 2: gemm_phase(u, DFF, wb + O_WO1, DFF, DFF, T_, DM, EpiResid{x, 0.5f}, bid, nblk); break;
      case 3: phase_norm(x, nullptr, p.in[4] + layer * DM, h); break;
      case 4: gemm_phase(h, DM, wb + O_WIN, DM, DM, T_, UW, EpiStoreBf16{u, UW}, bid, nblk); break;
      case 5: {
        for (int it = bid; it < 512; it += nblk) post_tile(p, layer, it);
        lru_phase(p, layer, 1, bid, nblk);
      } break;
      case 6: {
        u16* qm = (u16*)(p.ws + B_QM); u16* kvm = (u16*)(p.ws + B_KVM); u16* vtg = (u16*)(p.ws + B_VTG);
        if (bid < 4) lru_carry(p, bid);
        float mcg = 8.f * gain_absmax(p.in[6] + layer * 64, 64) * gain_absmax(p.in[7] + layer * 64, 64) * LOG2E;
        if (mcg < 60.f) mcg = 0.f;
        const float csg = 0.125f * LOG2E;
        for (int it = bid; it < 1024; it += nblk) {
          int g = it & 3, qt = (it >> 2) & 63, kvh = (it >> 8) & 1, b = it >> 9;
          int hq = kvh * 4 + g;
          attn_tile<64>(u + (size_t)b * S_ * UW + UQ + hq * 64, UW, u + (size_t)b * S_ * UW + UK + kvh * 64, UW,
                        vtg + (size_t)(b * 2 + kvh) * 64 * S_, u + (size_t)b * S_ * UW + UQ + hq * 64, UW, qt * 256, csg, mcg);
        }
        {
          unsigned* qc = (unsigned*)(p.ws + B_BAR) + 1 + layer * 9 + 8;
          volatile LAS unsigned* qslot = (volatile LAS unsigned*)&xb_words.z;
          for (;;) {
            if (threadIdx.x == 0) *qslot = atomicAdd(qc, 1u);
            __syncthreads();
            const int tk = (int)*qslot;
            if (tk >= 768 + 1024) break;
            if (tk < 768) {
              int pm, pn; tile_map(tk, 128, 6, pm, pn);
              gemm_tile(u + UQLAT, UW, wb + O_WQUP, 384, 384, pm * BM, pn * BN, EpiStoreBf16{qm, 768});
            } else {
              int pm, pn; tile_map(tk - 768, 128, 8, pm, pn);
              gemm_tile(u + UKVLAT, UW, wb + O_WKVUP, 256, 256, pm * BM, pn * BN, EpiStoreBf16{kvm, 1024});
            }
          }
        }
      } break;
      case 7: {
        for (int it = bid; it < 512; it += nblk) mla_post_tile(p, layer, it);
      } break;
      case 8: {
        u16* qm = (u16*)(p.ws + B_QM); u16* kvm = (u16*)(p.ws + B_KVM); u16* vtm = (u16*)(p.ws + B_VTM);
        const float sq96 = 9.797958971132712f;
        float mcm = sq96 * gain_absmax(p.in[14] + layer * 96, 96) * gain_absmax(p.in[15] + layer * 96, 96) * LOG2E;
        if (mcm < 60.f) mcm = 0.f;
        const float csm = (1.f / sq96) * LOG2E;
        for (int it = bid; it < 1024; it += nblk) {
          int qt = it & 63, hd = (it >> 6) & 7, b = it >> 9;
          attn_tile<96>(qm + (size_t)b * S_ * 768 + hd * 96, 768, kvm + (size_t)b * S_ * 1024 + hd * 128, 1024,
                        vtm + (size_t)(b * 8 + hd) * 64 * S_, u + (size_t)b * S_ * UW + UQLAT + hd * 64, UW, qt * 256, csm, mcm);
        }
        lru_phase(p, layer, 3, bid, nblk, (unsigned*)(p.ws + B_BAR) + 1 + layer * 9, (volatile LAS unsigned*)&xb_words.z);
      } break;
      case 9: {
        u16* merged = (u16*)(p.ws + B_MERGED);
        int round9 = 0;
        for (int tile = bid; tile < 128 * 8; tile += nblk, ++round9) {
          int pm, pn;
          if (!tile_map_xcd(bid, nblk, round9, 128, 8, pm, pn)) tile_map(tile, 128, 8, pm, pn);
          unsigned macc[32];
#pragma unroll
          for (int e = 0; e < 32; ++e) macc[e] = 0u;
#pragma unroll 1
          for (int n = 0; n < 4; ++n) {
            const int brc = (n == 0) ? UQ : (n == 1) ? USC : (n == 2) ? UQLAT : ULRU;
            unsigned gp[32];
            gemm_tile<false>(h, DM, wb + O_WIN + (size_t)(4096 + n * 1024) * DM, DM, DM, pm * BM, pn * BN, EpiGateReg{gp});
            gemm_tile<false>(u + brc, UW, wb + O_WBR + (size_t)n * 1024 * 512, 512, 512, pm * BM, pn * BN, EpiMergeReg{gp, macc});
          }
          {
            const int tid = tid_();
            const int wid = tid >> 6, lane = tid & 63, wr = wid >> 1, wc = wid & 1, fr = lane & 15, fq = lane >> 4;
#pragma unroll
            for (int m = 0; m < 4; ++m)
#pragma unroll
              for (int n = 0; n < 4; ++n) {
                const int e = (m * 4 + n) * 2;
                int row = pm * BM + wr * 64 + m * 16 + fr, col = pn * BN + wc * 64 + n * 16 + fq * 4;
                uint2 v = {macc[e], macc[e + 1]};
                *(uint2*)(merged + (unsigned)(row * DM + col)) = v;
              }
          }
        }
      } break;
      case 10: gemm_phase((u16*)(p.ws + B_MERGED), DM, wb + O_WOUT, DM, DM, T_, DM, EpiResid{x, 1.0f}, bid, nblk); break;
      case 11: phase_norm(x, nullptr, p.in[25] + layer * DM, h); break;
      case 12: gemm_phase(h, DM, wb + O_WI2, DM, DM, T_, 2 * DFF, EpiSwiglu{u}, bid, nblk); break;
      case 13: gemm_phase(u, DFF, wb + O_WO2, DFF, DFF, T_, DM, EpiResid{x, 0.5f}, bid, nblk); break;
    }
    xcd_barrier(xb);
  }
}

constexpr size_t kDynLds = 147456;

extern "C" void kernel_launch(void* const* d_in, const int* in_sizes, int n_in, void* d_out, int out_size, void* d_ws, size_t ws_size,
                              hipStream_t stream) {
  static int grid_blocks = 0;
  if (!grid_blocks) {
    int dev = 0, cus = 0, per_cu = 0;
    hipGetDevice(&dev);
    hipDeviceGetAttribute(&cus, hipDeviceAttributeMultiprocessorCount, dev);
    hipFuncSetAttribute((const void*)fwd_megakernel, hipFuncAttributeMaxDynamicSharedMemorySize, (int)kDynLds);
    hipOccupancyMaxActiveBlocksPerMultiprocessor(&per_cu, fwd_megakernel, NTHR, kDynLds);
    if (per_cu < 1) per_cu = 1;
    grid_blocks = cus * per_cu;
    if (grid_blocks > MAXGRID) grid_blocks = MAXGRID;
    if (B_END > ws_size) fprintf(stderr, "workspace too small: need %zu have %zu\n", (size_t)B_END, ws_size);
  }
  Params p{};
  for (int i = 0; i < 28; ++i) p.in[i] = (const float*)d_in[i];
  p.out = (float*)d_out;
  p.ws = (char*)d_ws;
  (void)hipMemsetAsync((char*)d_ws + B_BAR, 0, BAR_BYTES, stream);
  void* args[] = {&p};
  hipError_t e = hipLaunchCooperativeKernel((void*)fwd_megakernel, dim3(grid_blocks), dim3(NTHR), args, kDynLds, stream);
  if (e != hipSuccess) fprintf(stderr, "cooperative launch failed: %s (grid %d)\n", hipGetErrorString(e), grid_blocks);
}
```

```cpp
#include <hip/hip_runtime.h>
#include <hip/hip_bf16.h>
#include <hip/hip_cooperative_groups.h>
#include <cstdio>
namespace cg = cooperative_groups;

typedef unsigned short u16;
using bf16x8 = __attribute__((ext_vector_type(8))) short;
using f32x4 = __attribute__((ext_vector_type(4))) float;
using f32x16 = __attribute__((ext_vector_type(16))) float;
typedef __bf16 bf16x2_t __attribute__((ext_vector_type(2)));
typedef float f32x2_t __attribute__((ext_vector_type(2)));
#define DI __device__ __forceinline__

constexpr int T_ = 32768, S_ = 16384, DM = 1024, DFF = 2816, NL = 4;
constexpr int UW = 4096;
constexpr int UQ = 0, UK = 512, UV = 640, USC = 768, UQLAT = 2304, UKVLAT = 2688, ULRU = 2944, UKROPE = 3968;
constexpr int NTHR = 512;
constexpr int MAXGRID = 256;

constexpr size_t O_WI1 = 0;
constexpr size_t O_WO1 = O_WI1 + (size_t)5632 * 1024;
constexpr size_t O_WIN = O_WO1 + (size_t)1024 * 2816;
constexpr size_t O_WQUP = O_WIN + (size_t)8192 * 1024;
constexpr size_t O_WKVUP = O_WQUP + (size_t)768 * 384;
constexpr size_t O_WBR = O_WKVUP + (size_t)1024 * 256;
constexpr size_t O_WOUT = O_WBR + (size_t)4 * 1024 * 512;
constexpr size_t O_WI2 = O_WOUT + (size_t)1024 * 1024;
constexpr size_t O_WO2 = O_WI2 + (size_t)5632 * 1024;
constexpr size_t W_ELEMS = O_WO2 + (size_t)1024 * 2816;

constexpr size_t AL(size_t x) { return (x + 255) & ~(size_t)255; }
constexpr size_t B_WB = 0;
constexpr size_t B_H = AL(B_WB + W_ELEMS * 2);
constexpr size_t B_U = AL(B_H + (size_t)T_ * 1024 * 2);
constexpr size_t B_R = AL(B_U + (size_t)T_ * UW * 2);
constexpr size_t B_QM = B_R;
constexpr size_t B_KVM = AL(B_QM + (size_t)T_ * 768 * 2);
constexpr size_t B_VTM = AL(B_KVM + (size_t)T_ * 1024 * 2);
constexpr size_t B_VTG = AL(B_VTM + (size_t)T_ * 512 * 2);
constexpr size_t B_MERGED = B_R;
constexpr size_t B_SCR = AL(B_MERGED + (size_t)T_ * 1024 * 2);
constexpr size_t SCR_PER_BLOCK = (size_t)NTHR * 192 * 4;
constexpr size_t B_REND1 = AL(B_VTG + (size_t)T_ * 128 * 2);
constexpr size_t B_REND2 = AL(B_SCR + SCR_PER_BLOCK * MAXGRID);
constexpr size_t B_SMALL = (B_REND1 > B_REND2 ? B_REND1 : B_REND2);
constexpr size_t B_TABG_R = B_SMALL;
constexpr size_t B_TABG_C = AL(B_TABG_R + 256 * 16 * 8);
constexpr size_t B_TABM_R = AL(B_TABG_C + 64 * 16 * 8);
constexpr size_t B_TABM_C = AL(B_TABM_R + 256 * 8 * 8);
constexpr size_t B_SUMM = AL(B_TABM_C + 64 * 8 * 8);
constexpr size_t B_CARRY = AL(B_SUMM + (size_t)2 * 2 * 256 * 512 * 8);
constexpr size_t B_BAR = AL(B_CARRY + (size_t)2 * 2 * 256 * 512 * 4);
constexpr size_t BAR_BYTES = 3456 * 4;
constexpr size_t B_END = AL(B_BAR + BAR_BYTES);

struct Params {
  const float* in[28];
  float* out;
  char* ws;
};

typedef const __attribute__((address_space(4))) Params CParams;

DI u16 f2bf(float x) { unsigned u = __float_as_uint(x); u += 0x7fffu + ((u >> 16) & 1u); return (u16)(u >> 16); }
DI float bf2f(u16 b) { return __uint_as_float(((unsigned)b) << 16); }
DI unsigned pack2(float a, float b) { f32x2_t v = {a, b}; bf16x2_t r = __builtin_convertvector(v, bf16x2_t); return __builtin_bit_cast(unsigned, r); }
DI float lo2f(unsigned p) { return __uint_as_float(p << 16); }
DI float hi2f(unsigned p) { return __uint_as_float(p & 0xffff0000u); }
DI float shx(float v, int o, int lane) { return __int_as_float(__builtin_amdgcn_ds_bpermute((lane ^ o) << 2, __float_as_int(v))); }
DI float wave_sum(float v, int lane) {
#pragma unroll
  for (int o = 32; o >= 1; o >>= 1) v += shx(v, o, lane);
  return v;
}
typedef unsigned v2u_t __attribute__((ext_vector_type(2)));
DI float wsum_dpp(float v) {
  v += __int_as_float(__builtin_amdgcn_update_dpp(0, __float_as_int(v), 0xB1, 0xF, 0xF, true));
  v += __int_as_float(__builtin_amdgcn_update_dpp(0, __float_as_int(v), 0x4E, 0xF, 0xF, true));
  v += __int_as_float(__builtin_amdgcn_update_dpp(0, __float_as_int(v), 0x141, 0xF, 0xF, true));
  v += __int_as_float(__builtin_amdgcn_update_dpp(0, __float_as_int(v), 0x140, 0xF, 0xF, true));
  v2u_t a = __builtin_amdgcn_permlane16_swap(__float_as_uint(v), __float_as_uint(v), false, false);
  v = __uint_as_float(a[0]) + __uint_as_float(a[1]);
  v2u_t b = __builtin_amdgcn_permlane32_swap(__float_as_uint(v), __float_as_uint(v), false, false);
  return __uint_as_float(b[0]) + __uint_as_float(b[1]);
}
DI float xor16_(float y, int lane) {
  v2u_t a = __builtin_amdgcn_permlane16_swap(__float_as_uint(y), __float_as_uint(y), false, false);
  return (lane & 16) ? __uint_as_float(a[0]) : __uint_as_float(a[1]);
}
DI float xor4_(float y) {
  float t = __int_as_float(__builtin_amdgcn_update_dpp(0, __float_as_int(y), 0x141, 0xF, 0xF, true));
  return __int_as_float(__builtin_amdgcn_update_dpp(0, __float_as_int(t), 0x1B, 0xF, 0xF, true));
}
DI float rcp_(float x) { return __builtin_amdgcn_rcpf(x); }
DI float sigmoidf_(float x) { return rcp_(1.f + __expf(-x)); }
DI float softplus_neg(float lm) {
  float e = __expf(-lm);
  return (e < 0.03f) ? e * (1.f - e * (0.5f - e * (1.f / 3.f - 0.25f * e))) : __logf(1.f + e);
}
DI float one_minus_exp(float z) {
  return (z > -0.25f) ? -z * (1.f + z * (0.5f + z * (1.f / 6.f + z * (1.f / 24.f + z * (1.f / 120.f))))) : 1.f - __expf(z);
}
DI float tanh_(float y) { return 1.f - 2.f * rcp_(1.f + __expf(2.f * y)); }
DI int tid_() { int t = threadIdx.x; asm volatile("" : "+v"(t)); return t; }
DI int permkey(int k) { return (k & ~12) | ((k & 4) << 1) | ((k & 8) >> 1); }

constexpr int BM = 256, BK = 64, HALF = 128, HT = HALF * BK;
DI int lds_byte(int r, int c) {
  int st = (r >> 4) * 2 + (c >> 5), rr = r & 15, cc = c & 31, ob = rr * 64 + cc * 2;
  return st * 1024 + (ob ^ (((ob >> 9) & 1) << 5));
}
DI void stage_rc(int b, int& R, int& C) {
  int st = b / 1024, sb = b % 1024, swz = sb ^ (((sb >> 9) & 1) << 5);
  R = (st >> 1) * 16 + swz / 64; C = (st & 1) * 32 + (swz % 64) / 2;
}

typedef f32x4 acc_t[4][4];
constexpr int BN = 128;

template <bool LOWREG = false, class Epi>
DI void gemm_tile(const u16* __restrict__ A, int lda, const u16* __restrict__ Bt, int ldb, int K, int brow, int bcol, Epi epi,
               bool preloaded = false, bool hasNext = false, int nbrow = 0, int nbcol = 0) {
  const int tid = tid_();
  extern __shared__ __attribute__((aligned(16))) char smem[];
  u16* shm = (u16*)smem;
#define SA(b, h) (shm + ((b) * 3 + (h)) * HT)
#define SB(b) (shm + ((b) * 3 + 2) * HT)
#define STAGE(P, BASE, LD, br, kt, O0, O1) do { const u16* _gb = (BASE) + (size_t)(br) * (LD) + (size_t)(kt) * BK; \
    __builtin_amdgcn_global_load_lds((const unsigned*)(_gb + (O0)), (__attribute__((address_space(3))) unsigned*)((char*)(P) + tid * 16), 16, 0, 0); \
    __builtin_amdgcn_global_load_lds((const unsigned*)(_gb + (O1)), (__attribute__((address_space(3))) unsigned*)((char*)(P) + tid * 16 + 8192), 16, 0, 0); } while (0)
#define STAGEA(P, br, kt) STAGE(P, A, lda, br, kt, oA0, oA1)
#define STAGEB(P, br, kt) STAGE(P, Bt, ldb, br, kt, oB0, oB1)
#define STAGE_ALL(bufi, kt) do { STAGEA(SA(bufi, 0), brow, kt); STAGEA(SA(bufi, 1), brow + HALF, kt); STAGEB(SB(bufi), bcol, kt); } while (0)
#define STAGE_NEXT(bufi, kt) do { STAGEA(SA(bufi, 0), nbrow, kt); STAGEA(SA(bufi, 1), nbrow + HALF, kt); STAGEB(SB(bufi), nbcol, kt); } while (0)
#define WAIT_V(n) asm volatile("s_waitcnt vmcnt(" #n ")" ::: "memory")
#define BAR __builtin_amdgcn_s_barrier()

  if (!preloaded) {
    asm volatile("s_waitcnt vmcnt(0)" ::: "memory");
    __syncthreads();
  }
  const int wid = tid >> 6, lane = tid & 63, wr = wid >> 1, wc = wid & 1, fr = lane & 15, fq = lane >> 4;
  acc_t acc;
#pragma unroll
  for (int m = 0; m < 4; ++m)
#pragma unroll
    for (int n = 0; n < 4; ++n) acc[m][n] = f32x4{0.f, 0.f, 0.f, 0.f};
  const int nt = K / BK;
  unsigned oA0, oA1, oB0, oB1;
  { int _r, _c; stage_rc(tid * 16, _r, _c); oA0 = _r * lda + _c; oB0 = _r * ldb + _c;
    stage_rc(tid * 16 + 8192, _r, _c); oA1 = _r * lda + _c; oB1 = _r * ldb + _c; }
  if (!preloaded) {
    STAGE_ALL(0, 0);
    if (nt > 1) STAGE_ALL(1, 1);
  }
  int b = 0;
  if (LOWREG) {
#pragma unroll 1
    for (int t = 0; t < nt; ++t) {
      if (t + 1 < nt) WAIT_V(6); else WAIT_V(0);
      BAR;
      if (t + 2 < nt) { const int b2 = (b == 0) ? 2 : b - 1; STAGE_ALL(b2, t + 2); }
      const char* pa = (const char*)SA(b, wr >> 1);
      const char* pb = (const char*)SB(b);
#pragma unroll
      for (int k = 0; k < 2; ++k) {
        bf16x8 At[4], Bf[4];
#pragma unroll
        for (int m = 0; m < 4; ++m) At[m] = *reinterpret_cast<const bf16x8*>(pa + lds_byte((wr & 1) * 64 + m * 16 + fr, k * 32 + fq * 8));
#pragma unroll
        for (int n = 0; n < 4; ++n) Bf[n] = *reinterpret_cast<const bf16x8*>(pb + lds_byte(wc * 64 + n * 16 + fr, k * 32 + fq * 8));
#pragma unroll
        for (int m = 0; m < 4; ++m)
#pragma unroll
          for (int n = 0; n < 4; ++n) acc[m][n] = __builtin_amdgcn_mfma_f32_16x16x32_bf16(Bf[n], At[m], acc[m][n], 0, 0, 0);
        __builtin_amdgcn_sched_barrier(0);
      }
      b = (b == 2) ? 0 : b + 1;
    }
  } else {
    const int grp = wid >> 2;
    if (nt > 1 && !preloaded) WAIT_V(6); else WAIT_V(0);
    __syncthreads();
    if (grp == 1) BAR;
#pragma unroll 1
    for (int t = 0; t < nt; ++t) {
      const char* pa = (const char*)SA(b, wr >> 1);
      const char* pb = (const char*)SB(b);
      bf16x8 At[4][2], Bf[4][2];
#pragma unroll
      for (int m = 0; m < 4; ++m)
#pragma unroll
        for (int k = 0; k < 2; ++k) At[m][k] = *reinterpret_cast<const bf16x8*>(pa + lds_byte((wr & 1) * 64 + m * 16 + fr, k * 32 + fq * 8));
#pragma unroll
      for (int n = 0; n < 4; ++n)
#pragma unroll
        for (int k = 0; k < 2; ++k) Bf[n][k] = *reinterpret_cast<const bf16x8*>(pb + lds_byte(wc * 64 + n * 16 + fr, k * 32 + fq * 8));
      if (t + 2 < nt) { const int b2 = (b == 0) ? 2 : b - 1; STAGE_ALL(b2, t + 2); WAIT_V(6); } else { WAIT_V(0); }
      asm volatile("s_waitcnt lgkmcnt(0)" ::: "memory");
      __builtin_amdgcn_sched_barrier(0);
      BAR;
      __builtin_amdgcn_sched_barrier(0);
      __builtin_amdgcn_s_setprio(1);
#pragma unroll
      for (int k = 0; k < 2; ++k)
#pragma unroll
        for (int m = 0; m < 4; ++m)
#pragma unroll
          for (int n = 0; n < 4; ++n) acc[m][n] = __builtin_amdgcn_mfma_f32_16x16x32_bf16(Bf[n][k], At[m][k], acc[m][n], 0, 0, 0);
      __builtin_amdgcn_s_setprio(0);
      __builtin_amdgcn_sched_barrier(0);
      BAR;
      __builtin_amdgcn_sched_barrier(0);
      b = (b == 2) ? 0 : b + 1;
    }
    if (hasNext) {
      STAGE_NEXT(0, 0);
      if (nt > 1) STAGE_NEXT(1, 1);
    }
    epi(acc, brow, bcol);
    if (grp == 0) BAR;
  }
  if (LOWREG) epi(acc, brow, bcol);
#undef SA
#undef SB
}

#define EPI_IDS const int tid = tid_(); const int wid = tid >> 6, lane = tid & 63, wr = wid >> 1, wc = wid & 1, fr = lane & 15, fq = lane >> 4; (void)wr; (void)wc; (void)fr; (void)fq;

struct EpiStoreBf16 {
  u16* out; int ld;
  DI void operator()(acc_t& acc, int brow, int bcol) const {
    EPI_IDS
#pragma unroll
    for (int m = 0; m < 4; ++m)
#pragma unroll
      for (int n = 0; n < 4; ++n) {
        int row = brow + wr * 64 + m * 16 + fr, col = bcol + wc * 64 + n * 16 + fq * 4;
        uint2 v = {pack2(acc[m][n][0], acc[m][n][1]), pack2(acc[m][n][2], acc[m][n][3])};
        *(uint2*)(out + (unsigned)(row * ld + col)) = v;
      }
  }
};
struct EpiSwiglu {
  u16* out;
  DI void operator()(acc_t& acc, int brow, int bcol) const {
    EPI_IDS
    const int cb = (bcol >> 7) * 64 + wc * 32;
#pragma unroll
    for (int m = 0; m < 4; ++m)
#pragma unroll
      for (int n = 0; n < 2; ++n) {
        int row = brow + wr * 64 + m * 16 + fr, col = cb + n * 16 + fq * 4;
        float r[4];
#pragma unroll
        for (int j = 0; j < 4; ++j) { float g = acc[m][n][j], u = acc[m][n + 2][j]; r[j] = g * sigmoidf_(g) * u; }
        uint2 v = {pack2(r[0], r[1]), pack2(r[2], r[3])};
        *(uint2*)(out + (unsigned)(row * DFF + col)) = v;
      }
  }
};
struct EpiResid {
  float* x; float c;
  DI void operator()(acc_t& acc, int brow, int bcol) const {
    EPI_IDS
    f32x4 v[16];
#pragma unroll
    for (int m = 0; m < 4; ++m)
#pragma unroll
      for (int n = 0; n < 4; ++n) {
        const int row = brow + wr * 64 + m * 16 + fr, col = bcol + wc * 64 + n * 16 + fq * 4;
        v[m * 4 + n] = *(const f32x4*)(x + (unsigned)(row * DM + col));
      }
    asm volatile("" : "+v"(v[0]), "+v"(v[1]), "+v"(v[2]), "+v"(v[3]), "+v"(v[4]), "+v"(v[5]), "+v"(v[6]), "+v"(v[7]));
    asm volatile("" : "+v"(v[8]), "+v"(v[9]), "+v"(v[10]), "+v"(v[11]), "+v"(v[12]), "+v"(v[13]), "+v"(v[14]), "+v"(v[15]));
#pragma unroll
    for (int m = 0; m < 4; ++m)
#pragma unroll
      for (int n = 0; n < 4; ++n) {
        const int row = brow + wr * 64 + m * 16 + fr, col = bcol + wc * 64 + n * 16 + fq * 4;
        f32x4 w = v[m * 4 + n];
        w[0] += c * acc[m][n][0]; w[1] += c * acc[m][n][1]; w[2] += c * acc[m][n][2]; w[3] += c * acc[m][n][3];
        *(f32x4*)(x + (unsigned)(row * DM + col)) = w;
      }
  }
};
struct EpiGateReg {
  unsigned* gp;
  DI void operator()(acc_t& acc, int brow, int bcol) const {
    int e = 0;
#pragma unroll
    for (int m = 0; m < 4; ++m)
#pragma unroll
      for (int n = 0; n < 4; ++n)
#pragma unroll
        for (int j = 0; j < 4; j += 2) { gp[e] = pack2(sigmoidf_(acc[m][n][j]), sigmoidf_(acc[m][n][j + 1])); ++e; }
  }
};
struct EpiMergeReg {
  const unsigned* gp; unsigned* macc;
  DI void operator()(acc_t& acc, int brow, int bcol) const {
    int e = 0;
#pragma unroll
    for (int m = 0; m < 4; ++m)
#pragma unroll
      for (int n = 0; n < 4; ++n)
#pragma unroll
        for (int j = 0; j < 4; j += 2) {
          macc[e] = pack2(lo2f(macc[e]) + lo2f(gp[e]) * acc[m][n][j], hi2f(macc[e]) + hi2f(gp[e]) * acc[m][n][j + 1]);
          ++e;
        }
  }
};

DI void tile_map(int tile, int nM, int nN, int& pm, int& pn) {
  const int WGM = 8;
  int nig = WGM * nN, gid = tile / nig, fm = gid * WGM, gsz = min(nM - fm, WGM);
  pm = fm + ((tile % nig) % gsz); pn = (tile % nig) / gsz;
}

DI int map_col(int mode, int np) {
  if (mode == 0) return np;
  if (mode == 1) { int tile = np >> 7, wc = (np >> 6) & 1, half = (np >> 5) & 1, c = np & 31; return half * DFF + tile * 64 + wc * 32 + c; }
  if (np < 2944) return np;
  if (np < 3968) return np + 32;
  if (np < 4000) return np - 1024;
  if (np < 4096) return -1;
  return np - 96;
}
DI void conv_tile(const float* __restrict__ src, u16* __restrict__ dst, int K, int Nsrc, int mode, int tile) {
  const int tid = tid_();
  extern __shared__ __attribute__((aligned(16))) char smem[];
  float* ts = (float*)smem;
  const int nkt = K / 128;
  const int nt_ = tile / nkt, kt = tile % nkt;
  const int n0 = nt_ * 32, k0 = kt * 128;
  const int ns = map_col(mode, n0);
  __syncthreads();
  {
    int n = tid & 31, k = tid >> 5;
    float v[8];
#pragma unroll
    for (int p = 0; p < 8; ++p) v[p] = (ns >= 0) ? src[(size_t)(k0 + k + 16 * p) * Nsrc + ns + n] : 0.f;
#pragma unroll
    for (int p = 0; p < 8; ++p) ts[(k + 16 * p) * 33 + n] = v[p];
  }
  __syncthreads();
  {
    int n = tid >> 4, kc = (tid & 15) * 8;
    uint4 v;
    v.x = pack2(ts[(kc + 0) * 33 + n], ts[(kc + 1) * 33 + n]);
    v.y = pack2(ts[(kc + 2) * 33 + n], ts[(kc + 3) * 33 + n]);
    v.z = pack2(ts[(kc + 4) * 33 + n], ts[(kc + 5) * 33 + n]);
    v.w = pack2(ts[(kc + 6) * 33 + n], ts[(kc + 7) * 33 + n]);
    *(uint4*)(dst + (size_t)(n0 + n) * K + k0 + kc) = v;
  }
}
DI void phase_convert(CParams& p, int layer) {
  u16* wb = (u16*)(p.ws + B_WB);
  for (int item = blockIdx.x;; item += gridDim.x) {
    int t = item;
    const float* src; u16* dst; int K, Nsrc, Ndst, mode;
#define JOB(SRC, DST, K_, NSRC_, NDST_, MODE_) { int cnt = ((NDST_) / 32) * ((K_) / 128); if (t < cnt) { src = (SRC); dst = (DST); K = (K_); Nsrc = (NSRC_); Ndst = (NDST_); mode = (MODE_); goto found; } t -= cnt; }
    JOB(p.in[2] + (size_t)layer * 1024 * 5632, wb + O_WI1, 1024, 5632, 5632, 1)
    JOB(p.in[3] + (size_t)layer * 2816 * 1024, wb + O_WO1, 2816, 1024, 1024, 0)
    JOB(p.in[5] + (size_t)layer * 1024 * 8096, wb + O_WIN, 1024, 8096, 8192, 2)
    JOB(p.in[11] + (size_t)layer * 384 * 768, wb + O_WQUP, 384, 768, 768, 0)
    JOB(p.in[13] + (size_t)layer * 256 * 1024, wb + O_WKVUP, 256, 1024, 1024, 0)
    JOB(p.in[23] + (size_t)(layer * 4 + 0) * 512 * 1024, wb + O_WBR + (size_t)0 * 1024 * 512, 512, 1024, 1024, 0)
    JOB(p.in[23] + (size_t)(layer * 4 + 1) * 512 * 1024, wb + O_WBR + (size_t)1 * 1024 * 512, 512, 1024, 1024, 0)
    JOB(p.in[23] + (size_t)(layer * 4 + 2) * 512 * 1024, wb + O_WBR + (size_t)2 * 1024 * 512, 512, 1024, 1024, 0)
    JOB(p.in[23] + (size_t)(layer * 4 + 3) * 512 * 1024, wb + O_WBR + (size_t)3 * 1024 * 512, 512, 1024, 1024, 0)
    JOB(p.in[24] + (size_t)layer * 1024 * 1024, wb + O_WOUT, 1024, 1024, 1024, 0)
    JOB(p.in[26] + (size_t)layer * 1024 * 5632, wb + O_WI2, 1024, 5632, 5632, 1)
    JOB(p.in[27] + (size_t)layer * 2816 * 1024, wb + O_WO2, 2816, 1024, 1024, 0)
#undef JOB
    break;
  found:
    (void)Ndst;
    conv_tile(src, dst, K, Nsrc, mode, t);
  }
}

DI void phase_tables(CParams& p) {
  const int tid = tid_();
  float2* gr = (float2*)(p.ws + B_TABG_R); float2* gc = (float2*)(p.ws + B_TABG_C);
  float2* mr = (float2*)(p.ws + B_TABM_R); float2* mc = (float2*)(p.ws + B_TABM_C);
  int gt = blockIdx.x * NTHR + tid, gs = gridDim.x * NTHR;
  for (int i = gt; i < 256 * 16; i += gs) { int pos = i >> 4, f = i & 15; float inv = __builtin_amdgcn_exp2f(-(float)(2 * f) / 32.f * 13.287712379549449f); float a = (float)pos * inv; gr[i] = make_float2(__cosf(a), __sinf(a)); }
  for (int i = gt; i < 64 * 16; i += gs) { int pos = i >> 4, f = i & 15; float inv = __builtin_amdgcn_exp2f(-(float)(2 * f) / 32.f * 13.287712379549449f); float a = (float)pos * inv; gc[i] = make_float2(__cosf(a), __sinf(a)); }
  for (int i = gt; i < 256 * 8; i += gs) { int pos = i >> 3, f = i & 7; float inv = __builtin_amdgcn_exp2f(-(float)(2 * f) / 16.f * 13.287712379549449f); float a = (float)pos * inv; mr[i] = make_float2(__cosf(a), __sinf(a)); }
  for (int i = gt; i < 64 * 8; i += gs) { int pos = i >> 3, f = i & 7; float inv = __builtin_amdgcn_exp2f(-(float)(2 * f) / 16.f * 13.287712379549449f); float a = (float)pos * inv; mc[i] = make_float2(__cosf(a), __sinf(a)); }
}

DI void phase_norm(const float* __restrict__ xsrc, float* __restrict__ xcopy, const float* __restrict__ g, u16* __restrict__ h) {
  const int tid = tid_();
  const int wid = tid >> 6, lane = tid & 63;
  for (int row = blockIdx.x * 8 + wid; row < T_; row += gridDim.x * 8) {
    const float4* xr = (const float4*)(xsrc + (size_t)row * DM);
    float4 v[4]; float ss = 0.f;
#pragma unroll
    for (int i = 0; i < 4; ++i) { v[i] = xr[lane + 64 * i]; ss += v[i].x * v[i].x + v[i].y * v[i].y + v[i].z * v[i].z + v[i].w * v[i].w; }
    ss = wsum_dpp(ss);
    float rs = rsqrtf(ss * (1.f / DM) + 1e-6f);
#pragma unroll
    for (int i = 0; i < 4; ++i) {
      float4 gg = ((const float4*)g)[lane + 64 * i];
      uint2 o = {pack2(v[i].x * rs * gg.x, v[i].y * rs * gg.y), pack2(v[i].z * rs * gg.z, v[i].w * rs * gg.w)};
      *(uint2*)(h + (size_t)row * DM + (lane + 64 * i) * 4) = o;
      if (xcopy) ((float4*)(xcopy + (size_t)row * DM))[lane + 64 * i] = v[i];
    }
  }
}

DI bool tile_map_xcd(int bid, int nblk, int round, int nM, int nN, int& pm, int& pn) {
  if (nblk != 256 || nM != 128 || (nN & 3)) return false;
  const int xcd = bid & 7, loc = bid >> 3, lr = loc & 7, lc = loc >> 3;
  const int ncg = nN >> 2;
  const int cg = round % ncg, rg = round / ncg;
  pm = xcd + 8 * (rg * 8 + lr); pn = cg * 4 + lc;
  return true;
}
template <class Epi>
DI void gemm_phase(const u16* A, int lda, const u16* Bt, int ldb, int K, int M, int N, Epi epi, int first, int stride) {
  const int nM = M / BM, nN = N / BN, ntile = nM * nN;
  int round = 0, pm = 0, pn = 0;
  if (first < ntile) { if (!tile_map_xcd(first, stride, 0, nM, nN, pm, pn)) tile_map(first, nM, nN, pm, pn); }
  for (int tile = first; tile < ntile; tile += stride, ++round) {
    const int nxt = tile + stride;
    const bool hasNext = nxt < ntile;
    int qm = 0, qn = 0;
    if (hasNext) { if (!tile_map_xcd(first, stride, round + 1, nM, nN, qm, qn)) tile_map(nxt, nM, nN, qm, qn); }
    gemm_tile(A, lda, Bt, ldb, K, pm * BM, pn * BN, epi, round > 0, hasNext, qm * BM, qn * BN);
    pm = qm; pn = qn;
  }
}

struct PostTok { u16 rh[10], rq[6], rk[4]; uint4 bg, cg[3], xs[3]; float2 cs; };
DI void post_load(const u16* __restrict__ u, int t, int s, int lane, const float2* tgr, const float2* tgc, PostTok& d) {
  const u16* ur = u + (size_t)t * UW;
  const int rowp = s >> 6, colp = s & 63;
  d.cs = (lane < 32) ? tgr[rowp * 16 + (lane & 15)] : tgc[colp * 16 + (lane & 15)];
#pragma unroll
  for (int hd = 0; hd < 10; ++hd) d.rh[hd] = ur[hd * 64 + lane];
#pragma unroll
  for (int k = 0; k < 6; ++k) d.rq[k] = ur[UQLAT + lane + 64 * k];
#pragma unroll
  for (int k = 0; k < 4; ++k) d.rk[k] = ur[UKVLAT + lane + 64 * k];
  const int c0 = lane * 8;
  d.bg = *(const uint4*)(ur + USC + c0);
#pragma unroll
  for (int k = 0; k < 3; ++k) {
    const int s2 = s + k - 1;
    if (s2 >= 0 && s2 < S_) {
      const u16* r2 = u + (size_t)(t + k - 1) * UW + USC;
      d.cg[k] = *(const uint4*)(r2 + 512 + c0); d.xs[k] = *(const uint4*)(r2 + 1024 + c0);
    } else { d.cg[k] = uint4{0, 0, 0, 0}; d.xs[k] = uint4{0, 0, 0, 0}; }
  }
}
DI void post_tile(CParams& p, int layer, int tile) {
  const int tid = tid_();
  extern __shared__ __attribute__((aligned(16))) char smem[];
  u16* u = (u16*)(p.ws + B_U);
  const float2* tgr = (const float2*)(p.ws + B_TABG_R); const float2* tgc = (const float2*)(p.ws + B_TABG_C);
  const int wid = tid >> 6, lane = tid & 63;
  const int tb = tile * 64;
  const int b = tb / S_, sb = tb % S_;
  const float* qn = p.in[6] + layer * 64; const float* kn = p.in[7] + layer * 64;
  const float* scw = p.in[8] + layer * 3 * 512; const float* scb = p.in[9] + layer * 512;
  const float* qan = p.in[10] + layer * 384; const float* kvan = p.in[12] + layer * 256;
  const float gq = qn[lane], gk = kn[lane];
  float qanr[6], kvanr[4], scwr[3][8], scbr[8];
#pragma unroll
  for (int k = 0; k < 6; ++k) qanr[k] = qan[lane + 64 * k];
#pragma unroll
  for (int k = 0; k < 4; ++k) kvanr[k] = kvan[lane + 64 * k];
#pragma unroll
  for (int e = 0; e < 8; ++e) { scbr[e] = scb[lane * 8 + e];
#pragma unroll
    for (int k = 0; k < 3; ++k) scwr[k][e] = scw[k * 512 + lane * 8 + e]; }
  __syncthreads();
  PostTok dA, dB;
  post_load(u, tb + wid * 8, sb + wid * 8, lane, tgr, tgc, dA);
#pragma unroll
  for (int i = 0; i < 8; ++i) {
    PostTok& d = (i & 1) ? dB : dA;
    PostTok& dn = (i & 1) ? dA : dB;
    const int tl = wid * 8 + i, t = tb + tl, s = sb + tl;
    if (i + 1 < 8) post_load(u, t + 1, s + 1, lane, tgr, tgc, dn);
    u16* ur = u + (size_t)t * UW;
    const float2 cs = d.cs;
    float xh[10], ss[12];
#pragma unroll
    for (int hd = 0; hd < 10; ++hd) { xh[hd] = bf2f(d.rh[hd]); ss[hd] = xh[hd] * xh[hd]; }
    float xq[6], xk[4];
    ss[10] = 0.f; ss[11] = 0.f;
#pragma unroll
    for (int k = 0; k < 6; ++k) { xq[k] = bf2f(d.rq[k]); ss[10] += xq[k] * xq[k]; }
#pragma unroll
    for (int k = 0; k < 4; ++k) { xk[k] = bf2f(d.rk[k]); ss[11] += xk[k] * xk[k]; }
#pragma unroll
    for (int c = 0; c < 12; ++c) ss[c] = wsum_dpp(ss[c]);
    float yh[10], prh[10];
#pragma unroll
    for (int hd = 0; hd < 10; ++hd) yh[hd] = xh[hd] * rsqrtf(ss[hd] * (1.f / 64.f) + 1e-6f) * (hd < 8 ? gq : gk);
#pragma unroll
    for (int hd = 0; hd < 10; ++hd) prh[hd] = xor16_(yh[hd], lane);
#pragma unroll
    for (int hd = 0; hd < 10; ++hd) {
      float o = yh[hd] * cs.x + ((lane & 16) ? prh[hd] : -prh[hd]) * cs.y;
      if (hd < 8) o *= 0.125f * 1.4426950408889634f;
      ur[hd * 64 + lane] = f2bf(o);
    }
    {
      float rs = rsqrtf(ss[10] * (1.f / 384.f) + 1e-6f);
#pragma unroll
      for (int k = 0; k < 6; ++k) ur[UQLAT + lane + 64 * k] = f2bf(xq[k] * rs * qanr[k]);
      float rs2 = rsqrtf(ss[11] * (1.f / 256.f) + 1e-6f);
#pragma unroll
      for (int k = 0; k < 4; ++k) ur[UKVLAT + lane + 64 * k] = f2bf(xk[k] * rs2 * kvanr[k]);
    }
    {
      const int c0 = lane * 8;
      float accv[8];
#pragma unroll
      for (int e = 0; e < 8; ++e) accv[e] = scbr[e];
#pragma unroll
      for (int k = 0; k < 3; ++k) {
        const unsigned cgs[4] = {d.cg[k].x, d.cg[k].y, d.cg[k].z, d.cg[k].w}; const unsigned xss[4] = {d.xs[k].x, d.xs[k].y, d.xs[k].z, d.xs[k].w};
#pragma unroll
        for (int e = 0; e < 4; ++e) {
          accv[2 * e] += scwr[k][2 * e] * (lo2f(cgs[e]) * lo2f(xss[e]));
          accv[2 * e + 1] += scwr[k][2 * e + 1] * (hi2f(cgs[e]) * hi2f(xss[e]));
        }
      }
      const uint4 bg = d.bg;
      uint4 o;
      o.x = pack2(lo2f(bg.x) * accv[0], hi2f(bg.x) * accv[1]);
      o.y = pack2(lo2f(bg.y) * accv[2], hi2f(bg.y) * accv[3]);
      o.z = pack2(lo2f(bg.z) * accv[4], hi2f(bg.z) * accv[5]);
      o.w = pack2(lo2f(bg.w) * accv[6], hi2f(bg.w) * accv[7]);
      *(uint4*)(ur + USC + c0) = o;
    }
  }
  {
    u16* ls = (u16*)smem;
    int tok = tid >> 3, ch = tid & 7;
    const u16* src = u + (size_t)(tb + tok) * UW + UV + ch * 16;
    uint4 a = *(const uint4*)src, c = *(const uint4*)(src + 8);
    const unsigned w[8] = {a.x, a.y, a.z, a.w, c.x, c.y, c.z, c.w};
    int pt = permkey(tok);
#pragma unroll
    for (int e = 0; e < 8; ++e) {
      ls[(ch * 16 + 2 * e) * 72 + pt] = (u16)(w[e] & 0xffff);
      ls[(ch * 16 + 2 * e + 1) * 72 + pt] = (u16)(w[e] >> 16);
    }
    __syncthreads();
    u16* vtg = (u16*)(p.ws + B_VTG);
#pragma unroll
    for (int k = 0; k < 2; ++k) {
      int idx = tid + 512 * k, row = idx >> 3, c8 = idx & 7;
      uint4 v = *(const uint4*)(ls + row * 72 + c8 * 8);
      *(uint4*)(vtg + ((size_t)(b * 2 + (row >> 6)) * 64 + (row & 63)) * S_ + sb + c8 * 8) = v;
    }
  }
}

DI void lru_phase(CParams& p, int layer, int pass, int bid, int nblk, unsigned* qctr = nullptr, volatile unsigned __attribute__((address_space(3)))* qslot = nullptr) {
  const int tid = tid_();
  extern __shared__ __attribute__((aligned(16))) char smem[];
  u16* xcb = (u16*)smem;
  float* xcf = (float*)(smem + 64 * 72 * 2);
  float* G = xcf + 64 * 64;
  float2* part = (float2*)(G + 4 * 64 * 64);
  u16* u = (u16*)(p.ws + B_U);
  const float* cw = p.in[16] + layer * 4 * 512; const float* cb = p.in[17] + layer * 512;
  const float* lam = p.in[22] + (size_t)layer * 2 * 512;
  const int wid = tid >> 6, lane = tid & 63;
  const int mi = wid >> 1, dh = wid & 1, r = lane & 31, hh = lane >> 5, mdir = mi >> 1;
  const int ctok = tid >> 3, ccg = (tid & 7) * 8;
  const int ec = tid & 63;
  const int sdir = tid >> 8, ssub = (tid >> 6) & 3;
  int nbPrev = -1;
  bf16x8 wf[4]; float bs = 0.f, sp0 = 0.f, sp1 = 0.f;
  float cwr[4][8], cbr[8];
  const int qcls = (bid >> 3) & 7;
#pragma unroll 1
  for (int item = bid;; item += nblk) {
    if (qctr) {
      if (tid == 0) *qslot = atomicAdd(qctr + qcls, 1u);
      __syncthreads();
      const unsigned tk = *qslot;
      if (tk >= 512u) break;
      item = (int)tk * 8 + qcls;
    } else if (item >= 4096) break;
    const int nb = item & 7, j = (item >> 3) & 255, b = item >> 11;
    const int c0 = nb * 64, s0 = j * 64;
    if (nb != nbPrev) {
      nbPrev = nb;
      const float* W = ((mi & 1) ? p.in[20] : p.in[18]) + ((size_t)((layer * 2 + mdir) * 8 + nb)) * 64 * 64;
      const float* bias = ((mi & 1) ? p.in[21] : p.in[19]) + (size_t)(layer * 2 + mdir) * 512 + c0;
#pragma unroll
      for (int ks = 0; ks < 4; ++ks) {
        unsigned bw[4];
#pragma unroll
        for (int jj = 0; jj < 4; ++jj) {
          float w0 = W[(16 * ks + 8 * hh + 2 * jj) * 64 + 32 * dh + r];
          float w1 = W[(16 * ks + 8 * hh + 2 * jj + 1) * 64 + 32 * dh + r];
          bw[jj] = pack2(w0, w1);
        }
        uint4 bq = {bw[0], bw[1], bw[2], bw[3]};
        wf[ks] = __builtin_bit_cast(bf16x8, bq);
      }
      bs = bias[32 * dh + r];
      sp0 = softplus_neg(lam[c0 + ec]); sp1 = softplus_neg(lam[512 + c0 + ec]);
#pragma unroll
      for (int e = 0; e < 8; ++e) {
        cbr[e] = cb[c0 + ccg + e];
#pragma unroll
        for (int k = 0; k < 4; ++k) cwr[k][e] = cw[k * 512 + c0 + ccg + e];
      }
    }
    __syncthreads();
    {
      float a[8];
#pragma unroll
      for (int e = 0; e < 8; ++e) a[e] = cbr[e];
#pragma unroll
      for (int k = 0; k < 4; ++k) {
        int s2 = s0 + ctok + k - 2;
        if (s2 >= 0 && s2 < S_) {
          uint4 xv = *(const uint4*)(u + (size_t)(b * S_ + s2) * UW + ULRU + 512 + c0 + ccg);
          const unsigned w[4] = {xv.x, xv.y, xv.z, xv.w};
#pragma unroll
          for (int e = 0; e < 4; ++e) {
            a[2 * e] += cwr[k][2 * e] * lo2f(w[e]);
            a[2 * e + 1] += cwr[k][2 * e + 1] * hi2f(w[e]);
          }
        }
      }
#pragma unroll
      for (int e = 0; e < 8; ++e) xcf[ctok * 64 + ccg + e] = a[e];
      uint4 o = {pack2(a[0], a[1]), pack2(a[2], a[3]), pack2(a[4], a[5]), pack2(a[6], a[7])};
      *(uint4*)(xcb + ctok * 72 + ccg) = o;
    }
    u16* gp = u + (size_t)(b * S_ + s0 + ctok) * UW + ULRU + c0 + ccg;
    uint4 gv = {0, 0, 0, 0};
    if (pass == 3) gv = *(const uint4*)gp;
    __syncthreads();
    {
      f32x16 acc0, acc1;
#pragma unroll
      for (int i = 0; i < 16; ++i) { acc0[i] = 0.f; acc1[i] = 0.f; }
#pragma unroll
      for (int ks = 0; ks < 4; ++ks) {
        bf16x8 a0 = *(const bf16x8*)(xcb + (r)*72 + 16 * ks + 8 * hh);
        bf16x8 a1 = *(const bf16x8*)(xcb + (32 + r) * 72 + 16 * ks + 8 * hh);
        acc0 = __builtin_amdgcn_mfma_f32_32x32x16_bf16(a0, wf[ks], acc0, 0, 0, 0);
        acc1 = __builtin_amdgcn_mfma_f32_32x32x16_bf16(a1, wf[ks], acc1, 0, 0, 0);
      }
#pragma unroll
      for (int i = 0; i < 16; ++i) {
        int row = (i & 3) + 8 * (i >> 2) + 4 * hh;
        G[(mi * 64 + row) * 64 + 32 * dh + r] = sigmoidf_(acc0[i] + bs);
        G[(mi * 64 + 32 + row) * 64 + 32 * dh + r] = sigmoidf_(acc1[i] + bs);
      }
    }
    __syncthreads();
    {
      const float* Ga = G + (2 * sdir) * 4096; float* Gb = G + (2 * sdir + 1) * 4096;
      const int tb = ssub * 16;
      const float sp = sdir ? sp1 : sp0;
      float av[16], bv[16];
#pragma unroll
      for (int k = 0; k < 16; ++k) {
        const int t = tb + (sdir ? 15 - k : k);
        const float rr = Ga[t * 64 + ec], ii = Gb[t * 64 + ec];
        const float la = -8.f * rr * sp;
        av[k] = __expf(la);
        bv[k] = __builtin_amdgcn_sqrtf(fmaxf(1.f - av[k] * av[k], 0.f)) * ii * xcf[t * 64 + ec];
      }
      float hv = 0.f, P = 1.f;
#pragma unroll
      for (int k = 0; k < 16; ++k) { hv = av[k] * hv + bv[k]; P *= av[k]; }
      part[(sdir * 4 + ssub) * 64 + ec] = make_float2(P, hv);
      __syncthreads();
      const size_t sidx = ((size_t)((b * 2 + sdir) * 256 + j)) * 512 + c0 + ec;
      if (pass == 1) {
        if (ssub == 0) {
          float Pt = 1.f, ht = 0.f;
#pragma unroll
          for (int q = 0; q < 4; ++q) { float2 pq = part[(sdir * 4 + (sdir ? 3 - q : q)) * 64 + ec]; ht = pq.x * ht + pq.y; Pt *= pq.x; }
          ((float2*)(p.ws + B_SUMM))[sidx] = make_float2(Pt, ht);
        }
      } else {
        float cin = ((const float*)(p.ws + B_CARRY))[sidx];
#pragma unroll
        for (int q = 0; q < 3; ++q) {
          const int sq = sdir ? 3 - q : q;
          const bool before = sdir ? (sq > ssub) : (sq < ssub);
          float2 pq = part[(sdir * 4 + sq) * 64 + ec];
          if (before) cin = pq.x * cin + pq.y;
        }
        hv = cin;
#pragma unroll
        for (int k = 0; k < 16; ++k) { const int t = tb + (sdir ? 15 - k : k); hv = av[k] * hv + bv[k]; Gb[t * 64 + ec] = hv; }
      }
    }
    if (pass == 3) {
      __syncthreads();
      const unsigned w[4] = {gv.x, gv.y, gv.z, gv.w};
      float o[8];
#pragma unroll
      for (int e = 0; e < 8; ++e) {
        float g = (e & 1) ? hi2f(w[e >> 1]) : lo2f(w[e >> 1]);
        float ge = 0.5f * g * (1.f + tanh_(0.7978845608028654f * (g + 0.044715f * g * g * g)));
        o[e] = ge * (G[(1 * 64 + ctok) * 64 + ccg + e] + G[(3 * 64 + ctok) * 64 + ccg + e]);
      }
      uint4 ov = {pack2(o[0], o[1]), pack2(o[2], o[3]), pack2(o[4], o[5]), pack2(o[6], o[7])};
      *(uint4*)gp = ov;
    }
  }
}
DI void lru_carry(CParams& p, int blk) {
  const int tid = tid_();
  int id = blk * NTHR + tid;
  int c = id & 511, dir = (id >> 9) & 1, b = id >> 10;
  const float2* __restrict__ sm = (const float2*)(p.ws + B_SUMM) + (size_t)(b * 2 + dir) * 256 * 512 + c;
  float* __restrict__ cr = (float*)(p.ws + B_CARRY) + (size_t)(b * 2 + dir) * 256 * 512 + c;
  float cin = 0.f;
#pragma unroll 1
  for (int k0 = 0; k0 < 256; k0 += 32) {
    float2 ab[32];
#pragma unroll
    for (int i = 0; i < 32; ++i) { const int j = dir ? 255 - (k0 + i) : (k0 + i); ab[i] = sm[(size_t)j * 512]; }
#pragma unroll
    for (int i = 0; i < 32; ++i) {
      const int j = dir ? 255 - (k0 + i) : (k0 + i);
      cr[(size_t)j * 512] = cin;
      cin = ab[i].x * cin + ab[i].y;
    }
  }
}

template <int D>
DI void attn_tile(const u16* __restrict__ Qp, int ldq, const u16* __restrict__ Kp, int ldk, const u16* __restrict__ Vt,
                  u16* __restrict__ Op, int ldo, int q0, float cs, float mc) {
  const int tid = tid_();
  extern __shared__ __attribute__((aligned(16))) char smem[];
  constexpr int KS = D * 2 + 16, VS = 144, KB = 64 * KS, VB = 64 * VS, BUF = KB + VB;
  constexpr int NKS = D / 16, CPR = D / 8;
  constexpr int NIT = S_ / 64;
  const int wid = tid >> 6, lane = tid & 63, r = lane & 31, hh = lane >> 5, grp = wid >> 2;
  __syncthreads();
  bf16x8 qf[NKS];
  {
    const u16* qr = Qp + (size_t)(q0 + wid * 32 + r) * ldq + 8 * hh;
#pragma unroll
    for (int ks = 0; ks < NKS; ++ks) qf[ks] = *(const bf16x8*)(qr + 16 * ks);
  }
  f32x16 o0, o1, s0, s1;
#pragma unroll
  for (int i = 0; i < 16; ++i) { o0[i] = 0.f; o1[i] = 0.f; }
  float lsum0 = 0.f, lsum1 = 0.f;
  uint4 kr0, kr1, vr;
  const int vrow = tid >> 3, vch = tid & 7;
  int krow0, kch0, krow1 = 0, kch1 = 0;
  if (D == 64) { krow0 = tid >> 3; kch0 = tid & 7; }
  else { krow0 = tid / CPR; kch0 = tid % CPR; int i2 = tid + 512; krow1 = i2 / CPR; kch1 = i2 % CPR; }
  const bool k2 = (D == 96) && (tid < 256);
  kr1 = uint4{0, 0, 0, 0};
#define LOADT(key0) do { kr0 = *(const uint4*)(Kp + (size_t)((key0) + krow0) * ldk + kch0 * 8); \
    if (k2) kr1 = *(const uint4*)(Kp + (size_t)((key0) + krow1) * ldk + kch1 * 8); \
    vr = *(const uint4*)(Vt + (size_t)vrow * S_ + (key0) + vch * 8); } while (0)
#define STORET(bufi) do { char* bb = smem + (bufi) * BUF; *(uint4*)(bb + krow0 * KS + kch0 * 16) = kr0; \
    if (k2) *(uint4*)(bb + krow1 * KS + kch1 * 16) = kr1; \
    *(uint4*)(bb + KB + vrow * VS + vch * 16) = vr; } while (0)
#define LOADKF(bufi) do { const char* kb_ = smem + (bufi) * BUF + r * KS + 16 * hh; \
    _Pragma("unroll") for (int ks = 0; ks < NKS; ++ks) { kf0[ks] = *(const bf16x8*)(kb_ + 32 * ks); kf1[ks] = *(const bf16x8*)(kb_ + 32 * KS + 32 * ks); } } while (0)
#define SMMA() do { const f32x16 z_ = {0.f, 0.f, 0.f, 0.f, 0.f, 0.f, 0.f, 0.f, 0.f, 0.f, 0.f, 0.f, 0.f, 0.f, 0.f, 0.f}; \
    s0 = __builtin_amdgcn_mfma_f32_32x32x16_bf16(kf0[0], qf[0], z_, 0, 0, 0); \
    s1 = __builtin_amdgcn_mfma_f32_32x32x16_bf16(kf1[0], qf[0], z_, 0, 0, 0); \
    _Pragma("unroll") for (int ks = 1; ks < NKS; ++ks) { s0 = __builtin_amdgcn_mfma_f32_32x32x16_bf16(kf0[ks], qf[ks], s0, 0, 0, 0); \
      s1 = __builtin_amdgcn_mfma_f32_32x32x16_bf16(kf1[ks], qf[ks], s1, 0, 0, 0); } } while (0)
#define BARX do { __builtin_amdgcn_sched_barrier(0); asm volatile("s_waitcnt lgkmcnt(0)" ::: "memory"); __builtin_amdgcn_s_barrier(); __builtin_amdgcn_sched_barrier(0); } while (0)
  bf16x8 kf0[NKS], kf1[NKS];
  LOADT(0); STORET(0);
  LOADT(64); STORET(1);
  __syncthreads();
  LOADT(128);
  LOADKF(0);
  SMMA();
  if (grp == 1) BARX;
#pragma unroll 1
  for (int it = 0; it < NIT; ++it) {
    bf16x8 pf[2][2];
    if (mc != 0.f) {
#pragma unroll
      for (int i = 0; i < 16; ++i) { s0[i] -= mc; s1[i] -= mc; }
    }
#pragma unroll
    for (int i = 0; i < 16; ++i) {
      s0[i] = __builtin_amdgcn_exp2f(s0[i]); s1[i] = __builtin_amdgcn_exp2f(s1[i]);
      lsum0 += s0[i]; lsum1 += s1[i];
    }
#pragma unroll
    for (int st = 0; st < 2; ++st) {
      uint4 a = {pack2(s0[8 * st], s0[8 * st + 1]), pack2(s0[8 * st + 2], s0[8 * st + 3]), pack2(s0[8 * st + 4], s0[8 * st + 5]), pack2(s0[8 * st + 6], s0[8 * st + 7])};
      uint4 c = {pack2(s1[8 * st], s1[8 * st + 1]), pack2(s1[8 * st + 2], s1[8 * st + 3]), pack2(s1[8 * st + 4], s1[8 * st + 5]), pack2(s1[8 * st + 6], s1[8 * st + 7])};
      pf[0][st] = __builtin_bit_cast(bf16x8, a); pf[1][st] = __builtin_bit_cast(bf16x8, c);
    }
    if (it + 2 < NIT) STORET((it + 2) & 3);
    if (it + 3 < NIT) LOADT((it + 3) * 64);
    if (it + 1 < NIT) LOADKF((it + 1) & 3);
    BARX;
    __builtin_amdgcn_s_setprio(1);
    {
      const char* vb = smem + (it & 3) * BUF + KB + r * VS + 16 * hh;
      bf16x8 v0[2], v1[2];
#pragma unroll
      for (int q = 0; q < 2; ++q) { v0[q] = *(const bf16x8*)(vb + 32 * q); v1[q] = *(const bf16x8*)(vb + 32 * VS + 32 * q); }
      if (it + 1 < NIT) SMMA();
#pragma unroll
      for (int q = 0; q < 2; ++q) {
        o0 = __builtin_amdgcn_mfma_f32_32x32x16_bf16(v0[q], pf[0][q], o0, 0, 0, 0);
        o1 = __builtin_amdgcn_mfma_f32_32x32x16_bf16(v1[q], pf[0][q], o1, 0, 0, 0);
      }
#pragma unroll
      for (int q = 0; q < 2; ++q) { v0[q] = *(const bf16x8*)(vb + 64 + 32 * q); v1[q] = *(const bf16x8*)(vb + 32 * VS + 64 + 32 * q); }
#pragma unroll
      for (int q = 0; q < 2; ++q) {
        o0 = __builtin_amdgcn_mfma_f32_32x32x16_bf16(v0[q], pf[1][q], o0, 0, 0, 0);
        o1 = __builtin_amdgcn_mfma_f32_32x32x16_bf16(v1[q], pf[1][q], o1, 0, 0, 0);
      }
    }
    __builtin_amdgcn_s_setprio(0);
    BARX;
  }
  if (grp == 0) BARX;
#undef LOADT
#undef STORET
#undef LOADKF
#undef SMMA
#undef BARX
  float lsum = lsum0 + lsum1;
  lsum += shx(lsum, 32, lane);
  const float inv = rcp_(lsum);
  u16* orow = Op + (size_t)(q0 + wid * 32 + r) * ldo;
#pragma unroll
  for (int g = 0; g < 4; ++g) {
    uint2 a = {pack2(o0[4 * g] * inv, o0[4 * g + 1] * inv), pack2(o0[4 * g + 2] * inv, o0[4 * g + 3] * inv)};
    uint2 c = {pack2(o1[4 * g] * inv, o1[4 * g + 1] * inv), pack2(o1[4 * g + 2] * inv, o1[4 * g + 3] * inv)};
    *(uint2*)(orow + 8 * g + 4 * hh) = a;
    *(uint2*)(orow + 32 + 8 * g + 4 * hh) = c;
  }
}

DI float gain_absmax(const float* g, int n) {
  float m = 0.f;
  for (int i = 0; i < n; ++i) m = fmaxf(m, fabsf(g[i]));
  return m;
}

struct MlaTok { unsigned qw[8], kw[8]; float2 c0, c1; };
DI void mla_load(const u16* __restrict__ u, const u16* __restrict__ qm, const u16* __restrict__ kvm, int t, int s, int lane, int e0, bool rl,
                 const float2* tmr, const float2* tmc, MlaTok& d) {
  const int rowp = s >> 6, colp = s & 63;
  d.c0 = float2{1.f, 0.f}; d.c1 = float2{1.f, 0.f};
  if (rl) {
    if (e0 < 16) { d.c0 = tmr[rowp * 8 + (e0 & 7)]; d.c1 = tmr[rowp * 8 + ((e0 + 1) & 7)]; }
    else { d.c0 = tmc[colp * 8 + (e0 & 7)]; d.c1 = tmc[colp * 8 + ((e0 + 1) & 7)]; }
  }
  const unsigned kro = rl ? *(const unsigned*)(u + (size_t)t * UW + UKROPE + e0) : 0u;
#pragma unroll
  for (int hd = 0; hd < 8; ++hd) {
    d.qw[hd] = (lane < 48) ? *(const unsigned*)(qm + (size_t)t * 768 + hd * 96 + 2 * lane) : 0u;
    d.kw[hd] = (lane < 32) ? *(const unsigned*)(kvm + (size_t)t * 1024 + hd * 128 + 2 * lane) : kro;
  }
}
DI void mla_post_tile(CParams& p, int layer, int tile) {
  const int tid = tid_();
  extern __shared__ __attribute__((aligned(16))) char smem[];
  u16* ls = (u16*)smem;
  u16* u = (u16*)(p.ws + B_U); u16* qm = (u16*)(p.ws + B_QM); u16* kvm = (u16*)(p.ws + B_KVM); u16* vtm = (u16*)(p.ws + B_VTM);
  const float2* tmr = (const float2*)(p.ws + B_TABM_R); const float2* tmc = (const float2*)(p.ws + B_TABM_C);
  const float* qn = p.in[14] + layer * 96; const float* kn = p.in[15] + layer * 96;
  const int wid = tid >> 6, lane = tid & 63;
  const int tb = tile * 64, b = tb / S_, sb = tb % S_;
  __syncthreads();
#pragma unroll
  for (int k = 0; k < 8; ++k) {
    int idx = tid + 512 * k, tok = idx >> 6, cc = idx & 63, hd = cc >> 3, dvc = (cc & 7) * 8;
    uint4 v = *(const uint4*)(kvm + (size_t)(tb + tok) * 1024 + hd * 128 + 64 + dvc);
    const unsigned w[4] = {v.x, v.y, v.z, v.w};
    int pt = permkey(tok);
#pragma unroll
    for (int e = 0; e < 4; ++e) {
      ls[(hd * 64 + dvc + 2 * e) * 72 + pt] = (u16)(w[e] & 0xffff);
      ls[(hd * 64 + dvc + 2 * e + 1) * 72 + pt] = (u16)(w[e] >> 16);
    }
  }
  __syncthreads();
  const int e0 = 2 * (lane - 32);
  const bool rl = lane >= 32 && lane < 48;
  float gq0 = 0.f, gq1 = 0.f, gk0 = 0.f, gk1 = 0.f;
  if (lane < 48) { gq0 = qn[2 * lane]; gq1 = qn[2 * lane + 1]; gk0 = kn[2 * lane]; gk1 = kn[2 * lane + 1]; }
  MlaTok mA, mB;
  mla_load(u, qm, kvm, tb + wid * 8, sb + wid * 8, lane, e0, rl, tmr, tmc, mA);
#pragma unroll
  for (int i = 0; i < 8; ++i) {
    MlaTok& d = (i & 1) ? mB : mA;
    MlaTok& dn = (i & 1) ? mA : mB;
    const int tl = wid * 8 + i, t = tb + tl;
    if (i + 1 < 8) mla_load(u, qm, kvm, t + 1, sb + tl + 1, lane, e0, rl, tmr, tmc, dn);
    const float2 c0 = d.c0, c1 = d.c1;
    float ss[16];
#pragma unroll
    for (int hd = 0; hd < 8; ++hd) {
      float a0 = lo2f(d.qw[hd]), a1 = hi2f(d.qw[hd]), b0 = lo2f(d.kw[hd]), b1 = hi2f(d.kw[hd]);
      ss[hd] = a0 * a0 + a1 * a1; ss[8 + hd] = b0 * b0 + b1 * b1;
    }
#pragma unroll
    for (int c = 0; c < 16; ++c) ss[c] = wsum_dpp(ss[c]);
    const float qsc = (1.f / 9.797958971132712f) * 1.4426950408889634f;
    const bool up = (e0 & 8) != 0;
#pragma unroll
    for (int hd = 0; hd < 8; ++hd) {
      {
        float rs = rsqrtf(ss[hd] * (1.f / 96.f) + 1e-6f);
        float y0 = lo2f(d.qw[hd]) * rs * gq0, y1 = hi2f(d.qw[hd]) * rs * gq1;
        float p0 = xor4_(y0), p1 = xor4_(y1);
        if (rl) { y0 = y0 * c0.x + (up ? p0 : -p0) * c0.y; y1 = y1 * c1.x + (up ? p1 : -p1) * c1.y; }
        if (lane < 48) *(unsigned*)(qm + (size_t)t * 768 + hd * 96 + 2 * lane) = pack2(y0 * qsc, y1 * qsc);
      }
      {
        float rs = rsqrtf(ss[8 + hd] * (1.f / 96.f) + 1e-6f);
        float y0 = lo2f(d.kw[hd]) * rs * gk0, y1 = hi2f(d.kw[hd]) * rs * gk1;
        float p0 = xor4_(y0), p1 = xor4_(y1);
        if (rl) { y0 = y0 * c0.x + (up ? p0 : -p0) * c0.y; y1 = y1 * c1.x + (up ? p1 : -p1) * c1.y; }
        if (lane < 48) *(unsigned*)(kvm + (size_t)t * 1024 + hd * 128 + 2 * lane) = pack2(y0, y1);
      }
    }
  }
#pragma unroll
  for (int k = 0; k < 8; ++k) {
    int idx = tid + 512 * k, row = idx >> 3, c8 = idx & 7;
    uint4 v = *(const uint4*)(ls + row * 72 + c8 * 8);
    *(uint4*)(vtm + ((size_t)(b * 8 + (row >> 6)) * 64 + (row & 63)) * S_ + sb + c8 * 8) = v;
  }
}


#define XB_TMO      128
#define XB_XCNT(j)  (256  + 64 * (j))
#define XB_XSUB(j)  (1280 + 64 * (j))
#define XB_XGEN(j)  (2304 + 64 * (j))
#define XB_TOP      3328
#define XB_TOPGEN   3392
#define XB_SPIN_CAP (1u << 24)
#define LAS __attribute__((address_space(3)))
DI unsigned xb_ld(unsigned* p) { return __hip_atomic_load(p, __ATOMIC_RELAXED, __HIP_MEMORY_SCOPE_AGENT); }
DI unsigned xb_add(unsigned* p, unsigned v) { return __hip_atomic_fetch_add(p, v, __ATOMIC_RELAXED, __HIP_MEMORY_SCOPE_AGENT); }
DI unsigned xb_xcc_id() { return (unsigned)__builtin_amdgcn_s_getreg((3 << 11) | 20) & 0xFu; }
#define XB_SPIN(cond, bar) do { unsigned _sp = 0; while (cond) { __builtin_amdgcn_s_sleep(1); \
    if ((++_sp & 255u) == 0u) { if (xb_ld(&(bar)[XB_TMO])) break; if (_sp > XB_SPIN_CAP) { atomicAdd(&(bar)[XB_TMO], 1u); break; } } } } while (0)
struct XcdBarrier { unsigned* bar; unsigned x; volatile LAS unsigned* st; };
DI XcdBarrier xcd_barrier_post(unsigned* bar, volatile LAS unsigned* st) {
  XcdBarrier b; b.bar = bar; b.x = xb_xcc_id(); b.st = st;
  if (threadIdx.x == 0) (void)xb_add(&bar[XB_XCNT(b.x)], 1u);
  return b;
}
DI void xcd_barrier_complete(unsigned* bar, unsigned x, unsigned& nloc, unsigned& nx) {
  const unsigned G = gridDim.x * gridDim.y * gridDim.z;
  unsigned sum, cnt, mine, sp = 0u;
  for (;;) {
    sum = 0u; cnt = 0u; mine = 0u;
#pragma unroll
    for (unsigned j = 0; j < 16; ++j) { const unsigned c = xb_ld(&bar[XB_XCNT(j)]); sum += c; cnt += (c > 0u) ? 1u : 0u; mine = (j == x) ? c : mine; }
    if (sum == G) break;
    __builtin_amdgcn_s_sleep(1);
    if ((++sp & 255u) == 0u) { if (xb_ld(&bar[XB_TMO])) break; if (sp > XB_SPIN_CAP) { atomicAdd(&bar[XB_TMO], 1u); break; } }
  }
  nloc = mine > 0u ? mine : 1u; nx = cnt > 0u ? cnt : 1u;
}
DI void xcd_barrier(const XcdBarrier& b) {
  asm volatile("s_waitcnt vmcnt(0)" ::: "memory");
  __syncthreads();
  if (threadIdx.x == 0) {
    unsigned* bar = b.bar;
    __builtin_amdgcn_s_waitcnt(0);
    unsigned nloc = b.st[0], nx = b.st[1];
    if (nloc == 0u) { xcd_barrier_complete(bar, b.x, nloc, nx); b.st[0] = nloc; b.st[1] = nx; }
    const unsigned old = xb_add(&bar[XB_XSUB(b.x)], 1u);
    const unsigned gen = old / nloc;
    if (old + 1u == (gen + 1u) * nloc) {
      __builtin_amdgcn_fence(__ATOMIC_RELEASE, "agent");
      asm volatile("s_waitcnt vmcnt(0)" ::: "memory");
      const unsigned og = xb_add(&bar[XB_TOP], 1u);
      const unsigned tg = og / nx;
      if (og + 1u == (tg + 1u) * nx) xb_add(&bar[XB_TOPGEN], 1u);
      else XB_SPIN(xb_ld(&bar[XB_TOPGEN]) == tg, bar);
      __builtin_amdgcn_fence(__ATOMIC_ACQUIRE, "agent");
      xb_add(&bar[XB_XGEN(b.x)], 1u);
      asm volatile("s_waitcnt vmcnt(0)" ::: "memory");
    } else {
      XB_SPIN(xb_ld(&bar[XB_XGEN(b.x)]) == gen, bar);
      __builtin_amdgcn_fence(__ATOMIC_ACQUIRE, "agent");
      asm volatile("s_waitcnt vmcnt(0)" ::: "memory");
    }
  }
  __syncthreads();
}

__global__ void __launch_bounds__(NTHR) fwd_megakernel(Params p_unused) {
  cg::grid_group grid = cg::this_grid();
  __shared__ uint4 xb_words;
  if (threadIdx.x == 0) xb_words = make_uint4(0u, 0u, 0u, 0u);
  __syncthreads();
  XcdBarrier xb = xcd_barrier_post((unsigned*)(((CParams*)__builtin_amdgcn_kernarg_segment_ptr())->ws + B_BAR), (volatile LAS unsigned*)&xb_words);
  grid.sync();
  const float LOG2E = 1.4426950408889634f;
  constexpr int NPH = 14;
#pragma unroll 1
  for (int step = 0; step < NL * NPH; ++step) {
    int layer = step / NPH; const int ph = step % NPH;
    asm volatile("" : "+s"(layer));
    int bid = blockIdx.x, nblk = gridDim.x;
    asm volatile("" : "+s"(bid)); asm volatile("" : "+s"(nblk));
    CParams* pp = (CParams*)__builtin_amdgcn_kernarg_segment_ptr();
    asm volatile("" : "+s"(pp));
    CParams& p = *pp;
    u16* wb = (u16*)(p.ws + B_WB);
    u16* h = (u16*)(p.ws + B_H);
    u16* u = (u16*)(p.ws + B_U);
    float* x = p.out;
    switch (ph) {
      case 0: {
        if (layer == 0) phase_tables(p);
        phase_convert(p, layer);
        phase_norm(layer == 0 ? p.in[0] : x, layer == 0 ? x : nullptr, p.in[1] + layer * DM, h);
      } break;
      case 1: gemm_phase(h, DM, wb + O_WI1, DM, DM, T_, 2 * DFF, EpiSwiglu{u}, bid, nblk); break;
      case 2: gemm_phase(u, DFF, wb + O_WO1, DFF, DFF, T_, DM, EpiResid{x, 0.5f}, bid, nblk); break;
      case 3: phase_norm(x, nullptr, p.in[4] + layer * DM, h); break;
      case 4: gemm_phase(h, DM, wb + O_WIN, DM, DM, T_, UW, EpiStoreBf16{u, UW}, bid, nblk); break;
      case 5: {
        for (int it = bid; it < 512; it += nblk) post_tile(p, layer, it);
        lru_phase(p, layer, 1, bid, nblk);
      } break;
      case 6: {
        u16* qm = (u16*)(p.ws + B_QM); u16* kvm = (u16*)(p.ws + B_KVM); u16* vtg = (u16*)(p.ws + B_VTG);
        if (bid < 4) lru_carry(p, bid);
        float mcg = 8.f * gain_absmax(p.in[6] + layer * 64, 64) * gain_absmax(p.in[7] + layer * 64, 64) * LOG2E;
        if (mcg < 60.f) mcg = 0.f;
        const float csg = 0.125f * LOG2E;
        for (int it = bid; it < 1024; it += nblk) {
          int g = it & 3, qt = (it >> 2) & 63, kvh = (it >> 8) & 1, b = it >> 9;
          int hq = kvh * 4 + g;
          attn_tile<64>(u + (size_t)b * S_ * UW + UQ + hq * 64, UW, u + (size_t)b * S_ * UW + UK + kvh * 64, UW,
                        vtg + (size_t)(b * 2 + kvh) * 64 * S_, u + (size_t)b * S_ * UW + UQ + hq * 64, UW, qt * 256, csg, mcg);
        }
        {
          unsigned* qc = (unsigned*)(p.ws + B_BAR) + 1 + layer * 9 + 8;
          volatile LAS unsigned* qslot = (volatile LAS unsigned*)&xb_words.z;
          for (;;) {
            if (threadIdx.x == 0) *qslot = atomicAdd(qc, 1u);
            __syncthreads();
            const int tk = (int)*qslot;
            if (tk >= 768 + 1024) break;
            if (tk < 768) {
              int pm, pn; tile_map(tk, 128, 6, pm, pn);
              gemm_tile(u + UQLAT, UW, wb + O_WQUP, 384, 384, pm * BM, pn * BN, EpiStoreBf16{qm, 768});
            } else {
              int pm, pn; tile_map(tk - 768, 128, 8, pm, pn);
              gemm_tile(u + UKVLAT, UW, wb + O_WKVUP, 256, 256, pm * BM, pn * BN, EpiStoreBf16{kvm, 1024});
            }
          }
        }
      } break;
      case 7: {
        for (int it = bid; it < 512; it += nblk) mla_post_tile(p, layer, it);
      } break;
      case 8: {
        u16* qm = (u16*)(p.ws + B_QM); u16* kvm = (u16*)(p.ws + B_KVM); u16* vtm = (u16*)(p.ws + B_VTM);
        const float sq96 = 9.797958971132712f;
        float mcm = sq96 * gain_absmax(p.in[14] + layer * 96, 96) * gain_absmax(p.in[15] + layer * 96, 96) * LOG2E;
        if (mcm < 60.f) mcm = 0.f;
        const float csm = (1.f / sq96) * LOG2E;
        for (int it = bid; it < 1024; it += nblk) {
          int qt = it & 63, hd = (it >> 6) & 7, b = it >> 9;
          attn_tile<96>(qm + (size_t)b * S_ * 768 + hd * 96, 768, kvm + (size_t)b * S_ * 1024 + hd * 128, 1024,
                        vtm + (size_t)(b * 8 + hd) * 64 * S_, u + (size_t)b * S_ * UW + UQLAT + hd * 64, UW, qt * 256, csm, mcm);
        }
        lru_phase(p, layer, 3, bid, nblk, (unsigned*)(p.ws + B_BAR) + 1 + layer * 9, (volatile LAS unsigned*)&xb_words.z);
      } break;
      case 9: {
        u16* merged = (u16*)(p.ws + B_MERGED);
        int round9 = 0;
        for (int tile = bid; tile < 128 * 8; tile += nblk, ++round9) {
          int pm, pn;
          if (!tile_map_xcd(bid, nblk, round9, 128, 8, pm, pn)) tile_map(tile, 128, 8, pm, pn);
          unsigned macc[32];
#pragma unroll
          for (int e = 0; e < 32; ++e) macc[e] = 0u;
#pragma unroll 1
          for (int n = 0; n < 4; ++n) {
            const int brc = (n == 0) ? UQ : (n == 1) ? USC : (n == 2) ? UQLAT : ULRU;
            unsigned gp[32];
            gemm_tile<false>(h, DM, wb + O_WIN + (size_t)(4096 + n * 1024) * DM, DM, DM, pm * BM, pn * BN, EpiGateReg{gp});
            gemm_tile<false>(u + brc, UW, wb + O_WBR + (size_t)n * 1024 * 512, 512, 512, pm * BM, pn * BN, EpiMergeReg{gp, macc});
          }
          {
            const int tid = tid_();
            const int wid = tid >> 6, lane = tid & 63, wr = wid >> 1, wc = wid & 1, fr = lane & 15, fq = lane >> 4;
#pragma unroll
            for (int m = 0; m < 4; ++m)
#pragma unroll
              for (int n = 0; n < 4; ++n) {
                const int e = (m * 4 + n) * 2;
                int row = pm * BM + wr * 64 + m * 16 + fr, col = pn * BN + wc * 64 + n * 16 + fq * 4;
                uint2 v = {macc[e], macc[e + 1]};
                *(uint2*)(merged + (unsigned)(row * DM + col)) = v;
              }
          }
        }
      } break;
      case 10: gemm_phase((u16*)(p.ws + B_MERGED), DM, wb + O_WOUT, DM, DM, T_, DM, EpiResid{x, 1.0f}, bid, nblk); break;
      case 11: phase_norm(x, nullptr, p.in[25] + layer * DM, h); break;
      case 12: gemm_phase(h, DM, wb + O_WI2, DM, DM, T_, 2 * DFF, EpiSwiglu{u}, bid, nblk); break;
      case 13: gemm_phase(u, DFF, wb + O_WO2, DFF, DFF, T_, DM, EpiResid{x, 0.5f}, bid, nblk); break;
    }
    xcd_barrier(xb);
  }
}

constexpr size_t kDynLds = 147456;

extern "C" void kernel_launch(void* const* d_in, const int* in_sizes, int n_in, void* d_out, int out_size, void* d_ws, size_t ws_size,
                              hipStream_t stream) {
  static int grid_blocks = 0;
  if (!grid_blocks) {
    int dev = 0, cus = 0, per_cu = 0;
    hipGetDevice(&dev);
    hipDeviceGetAttribute(&cus, hipDeviceAttributeMultiprocessorCount, dev);
    hipFuncSetAttribute((const void*)fwd_megakernel, hipFuncAttributeMaxDynamicSharedMemorySize, (int)kDynLds);
    hipOccupancyMaxActiveBlocksPerMultiprocessor(&per_cu, fwd_megakernel, NTHR, kDynLds);
    if (per_cu < 1) per_cu = 1;
    grid_blocks = cus * per_cu;
    if (grid_blocks > MAXGRID) grid_blocks = MAXGRID;
    if (B_END > ws_size) fprintf(stderr, "workspace too small: need %zu have %zu\n", (size_t)B_END, ws_size);
  }
  Params p{};
  for (int i = 0; i < 28; ++i) p.in[i] = (const float*)d_in[i];
  p.out = (float*)d_out;
  p.ws = (char*)d_ws;
  (void)hipMemsetAsync((char*)d_ws + B_BAR, 0, BAR_BYTES, stream);
  void* args[] = {&p};
  hipError_t e = hipLaunchCooperativeKernel((void*)fwd_megakernel, dim3(grid_blocks), dim3(NTHR), args, kDynLds, stream);
  if (e != hipSuccess) fprintf(stderr, "cooperative launch failed: %s (grid %d)\n", hipGetErrorString(e), grid_blocks);
}
```

```cpp
#include <hip/hip_runtime.h>
#include <hip/hip_bf16.h>
#include <hip/hip_cooperative_groups.h>
#include <cstdio>
namespace cg = cooperative_groups;

typedef unsigned short u16;
using bf16x8 = __attribute__((ext_vector_type(8))) short;
using f32x4 = __attribute__((ext_vector_type(4))) float;
using f32x16 = __attribute__((ext_vector_type(16))) float;
typedef __bf16 bf16x2_t __attribute__((ext_vector_type(2)));
typedef float f32x2_t __attribute__((ext_vector_type(2)));
#define DI __device__ __forceinline__

constexpr int T_ = 32768, S_ = 16384, DM = 1024, DFF = 2816, NL = 4;
constexpr int UW = 4096;
constexpr int UQ = 0, UK = 512, UV = 640, USC = 768, UQLAT = 2304, UKVLAT = 2688, ULRU = 2944, UKROPE = 3968;
constexpr int NTHR = 512;
constexpr int MAXGRID = 256;

constexpr size_t O_WI1 = 0;
constexpr size_t O_WO1 = O_WI1 + (size_t)5632 * 1024;
constexpr size_t O_WIN = O_WO1 + (size_t)1024 * 2816;
constexpr size_t O_WQUP = O_WIN + (size_t)8192 * 1024;
constexpr size_t O_WKVUP = O_WQUP + (size_t)768 * 384;
constexpr size_t O_WBR = O_WKVUP + (size_t)1024 * 256;
constexpr size_t O_WOUT = O_WBR + (size_t)4 * 1024 * 512;
constexpr size_t O_WI2 = O_WOUT + (size_t)1024 * 1024;
constexpr size_t O_WO2 = O_WI2 + (size_t)5632 * 1024;
constexpr size_t W_ELEMS = O_WO2 + (size_t)1024 * 2816;

constexpr size_t AL(size_t x) { return (x + 255) & ~(size_t)255; }
constexpr size_t B_WB = 0;
constexpr size_t B_H = AL(B_WB + W_ELEMS * 2);
constexpr size_t B_U = AL(B_H + (size_t)T_ * 1024 * 2);
constexpr size_t B_R = AL(B_U + (size_t)T_ * UW * 2);
constexpr size_t B_QM = B_R;
constexpr size_t B_KVM = AL(B_QM + (size_t)T_ * 768 * 2);
constexpr size_t B_VTM = AL(B_KVM + (size_t)T_ * 1024 * 2);
constexpr size_t B_VTG = AL(B_VTM + (size_t)T_ * 512 * 2);
constexpr size_t B_MERGED = B_R;
constexpr size_t B_SCR = AL(B_MERGED + (size_t)T_ * 1024 * 2);
constexpr size_t SCR_PER_BLOCK = (size_t)NTHR * 192 * 4;
constexpr size_t B_REND1 = AL(B_VTG + (size_t)T_ * 128 * 2);
constexpr size_t B_REND2 = AL(B_SCR + SCR_PER_BLOCK * MAXGRID);
constexpr size_t B_SMALL = (B_REND1 > B_REND2 ? B_REND1 : B_REND2);
constexpr size_t B_TABG_R = B_SMALL;
constexpr size_t B_TABG_C = AL(B_TABG_R + 256 * 16 * 8);
constexpr size_t B_TABM_R = AL(B_TABG_C + 64 * 16 * 8);
constexpr size_t B_TABM_C = AL(B_TABM_R + 256 * 8 * 8);
constexpr size_t B_SUMM = AL(B_TABM_C + 64 * 8 * 8);
constexpr size_t B_CARRY = AL(B_SUMM + (size_t)2 * 2 * 256 * 512 * 8);
constexpr size_t B_BAR = AL(B_CARRY + (size_t)2 * 2 * 256 * 512 * 4);
constexpr size_t BAR_BYTES = 3456 * 4;
constexpr size_t B_END = AL(B_BAR + BAR_BYTES);

struct Params {
  const float* in[28];
  float* out;
  char* ws;
};

typedef const __attribute__((address_space(4))) Params CParams;

DI u16 f2bf(float x) { unsigned u = __float_as_uint(x); u += 0x7fffu + ((u >> 16) & 1u); return (u16)(u >> 16); }
DI float bf2f(u16 b) { return __uint_as_float(((unsigned)b) << 16); }
DI unsigned pack2(float a, float b) { f32x2_t v = {a, b}; bf16x2_t r = __builtin_convertvector(v, bf16x2_t); return __builtin_bit_cast(unsigned, r); }
DI float lo2f(unsigned p) { return __uint_as_float(p << 16); }
DI float hi2f(unsigned p) { return __uint_as_float(p & 0xffff0000u); }
DI float shx(float v, int o, int lane) { return __int_as_float(__builtin_amdgcn_ds_bpermute((lane ^ o) << 2, __float_as_int(v))); }
DI float wave_sum(float v, int lane) {
#pragma unroll
  for (int o = 32; o >= 1; o >>= 1) v += shx(v, o, lane);
  return v;
}
typedef unsigned v2u_t __attribute__((ext_vector_type(2)));
DI float wsum_dpp(float v) {
  v += __int_as_float(__builtin_amdgcn_update_dpp(0, __float_as_int(v), 0xB1, 0xF, 0xF, true));
  v += __int_as_float(__builtin_amdgcn_update_dpp(0, __float_as_int(v), 0x4E, 0xF, 0xF, true));
  v += __int_as_float(__builtin_amdgcn_update_dpp(0, __float_as_int(v), 0x141, 0xF, 0xF, true));
  v += __int_as_float(__builtin_amdgcn_update_dpp(0, __float_as_int(v), 0x140, 0xF, 0xF, true));
  v2u_t a = __builtin_amdgcn_permlane16_swap(__float_as_uint(v), __float_as_uint(v), false, false);
  v = __uint_as_float(a[0]) + __uint_as_float(a[1]);
  v2u_t b = __builtin_amdgcn_permlane32_swap(__float_as_uint(v), __float_as_uint(v), false, false);
  return __uint_as_float(b[0]) + __uint_as_float(b[1]);
}
DI float xor16_(float y, int lane) {
  v2u_t a = __builtin_amdgcn_permlane16_swap(__float_as_uint(y), __float_as_uint(y), false, false);
  return (lane & 16) ? __uint_as_float(a[0]) : __uint_as_float(a[1]);
}
DI float xor4_(float y) {
  float t = __int_as_float(__builtin_amdgcn_update_dpp(0, __float_as_int(y), 0x141, 0xF, 0xF, true));
  return __int_as_float(__builtin_amdgcn_update_dpp(0, __float_as_int(t), 0x1B, 0xF, 0xF, true));
}
DI float rcp_(float x) { return __builtin_amdgcn_rcpf(x); }
DI float sigmoidf_(float x) { return rcp_(1.f + __expf(-x)); }
DI float softplus_neg(float lm) {
  float e = __expf(-lm);
  return (e < 0.03f) ? e * (1.f - e * (0.5f - e * (1.f / 3.f - 0.25f * e))) : __logf(1.f + e);
}
DI float one_minus_exp(float z) {
  return (z > -0.25f) ? -z * (1.f + z * (0.5f + z * (1.f / 6.f + z * (1.f / 24.f + z * (1.f / 120.f))))) : 1.f - __expf(z);
}
DI float tanh_(float y) { return 1.f - 2.f * rcp_(1.f + __expf(2.f * y)); }
DI int tid_() { int t = threadIdx.x; asm volatile("" : "+v"(t)); return t; }
DI int permkey(int k) { return (k & ~12) | ((k & 4) << 1) | ((k & 8) >> 1); }

constexpr int BM = 256, BK = 64, HALF = 128, HT = HALF * BK;
DI int lds_byte(int r, int c) {
  int st = (r >> 4) * 2 + (c >> 5), rr = r & 15, cc = c & 31, ob = rr * 64 + cc * 2;
  return st * 1024 + (ob ^ (((ob >> 9) & 1) << 5));
}
DI void stage_rc(int b, int& R, int& C) {
  int st = b / 1024, sb = b % 1024, swz = sb ^ (((sb >> 9) & 1) << 5);
  R = (st >> 1) * 16 + swz / 64; C = (st & 1) * 32 + (swz % 64) / 2;
}

typedef f32x4 acc_t[4][4];
constexpr int BN = 128;

template <bool LOWREG = false, class Epi>
DI void gemm_tile(const u16* __restrict__ A, int lda, const u16* __restrict__ Bt, int ldb, int K, int brow, int bcol, Epi epi,
               bool preloaded = false, bool hasNext = false, int nbrow = 0, int nbcol = 0) {
  const int tid = tid_();
  extern __shared__ __attribute__((aligned(16))) char smem[];
  u16* shm = (u16*)smem;
#define SA(b, h) (shm + ((b) * 3 + (h)) * HT)
#define SB(b) (shm + ((b) * 3 + 2) * HT)
#define STAGE(P, BASE, LD, br, kt, O0, O1) do { const u16* _gb = (BASE) + (size_t)(br) * (LD) + (size_t)(kt) * BK; \
    __builtin_amdgcn_global_load_lds((const unsigned*)(_gb + (O0)), (__attribute__((address_space(3))) unsigned*)((char*)(P) + tid * 16), 16, 0, 0); \
    __builtin_amdgcn_global_load_lds((const unsigned*)(_gb + (O1)), (__attribute__((address_space(3))) unsigned*)((char*)(P) + tid * 16 + 8192), 16, 0, 0); } while (0)
#define STAGEA(P, br, kt) STAGE(P, A, lda, br, kt, oA0, oA1)
#define STAGEB(P, br, kt) STAGE(P, Bt, ldb, br, kt, oB0, oB1)
#define STAGE_ALL(bufi, kt) do { STAGEA(SA(bufi, 0), brow, kt); STAGEA(SA(bufi, 1), brow + HALF, kt); STAGEB(SB(bufi), bcol, kt); } while (0)
#define STAGE_NEXT(bufi, kt) do { STAGEA(SA(bufi, 0), nbrow, kt); STAGEA(SA(bufi, 1), nbrow + HALF, kt); STAGEB(SB(bufi), nbcol, kt); } while (0)
#define WAIT_V(n) asm volatile("s_waitcnt vmcnt(" #n ")" ::: "memory")
#define BAR __builtin_amdgcn_s_barrier()

  if (!preloaded) {
    asm volatile("s_waitcnt vmcnt(0)" ::: "memory");
    __syncthreads();
  }
  const int wid = tid >> 6, lane = tid & 63, wr = wid >> 1, wc = wid & 1, fr = lane & 15, fq = lane >> 4;
  acc_t acc;
#pragma unroll
  for (int m = 0; m < 4; ++m)
#pragma unroll
    for (int n = 0; n < 4; ++n) acc[m][n] = f32x4{0.f, 0.f, 0.f, 0.f};
  const int nt = K / BK;
  unsigned oA0, oA1, oB0, oB1;
  { int _r, _c; stage_rc(tid * 16, _r, _c); oA0 = _r * lda + _c; oB0 = _r * ldb + _c;
    stage_rc(tid * 16 + 8192, _r, _c); oA1 = _r * lda + _c; oB1 = _r * ldb + _c; }
  if (!preloaded) {
    STAGE_ALL(0, 0);
    if (nt > 1) STAGE_ALL(1, 1);
  }
  int b = 0;
  if (LOWREG) {
#pragma unroll 1
    for (int t = 0; t < nt; ++t) {
      if (t + 1 < nt) WAIT_V(6); else WAIT_V(0);
      BAR;
      if (t + 2 < nt) { const int b2 = (b == 0) ? 2 : b - 1; STAGE_ALL(b2, t + 2); }
      const char* pa = (const char*)SA(b, wr >> 1);
      const char* pb = (const char*)SB(b);
#pragma unroll
      for (int k = 0; k < 2; ++k) {
        bf16x8 At[4], Bf[4];
#pragma unroll
        for (int m = 0; m < 4; ++m) At[m] = *reinterpret_cast<const bf16x8*>(pa + lds_byte((wr & 1) * 64 + m * 16 + fr, k * 32 + fq * 8));
#pragma unroll
        for (int n = 0; n < 4; ++n) Bf[n] = *reinterpret_cast<const bf16x8*>(pb + lds_byte(wc * 64 + n * 16 + fr, k * 32 + fq * 8));
#pragma unroll
        for (int m = 0; m < 4; ++m)
#pragma unroll
          for (int n = 0; n < 4; ++n) acc[m][n] = __builtin_amdgcn_mfma_f32_16x16x32_bf16(Bf[n], At[m], acc[m][n], 0, 0, 0);
        __builtin_amdgcn_sched_barrier(0);
      }
      b = (b == 2) ? 0 : b + 1;
    }
  } else {
    const int grp = wid >> 2;
    if (nt > 1 && !preloaded) WAIT_V(6); else WAIT_V(0);
    __syncthreads();
    if (grp == 1) BAR;
#pragma unroll 1
    for (int t = 0; t < nt; ++t) {
      const char* pa = (const char*)SA(b, wr >> 1);
      const char* pb = (const char*)SB(b);
      bf16x8 At[4][2], Bf[4][2];
#pragma unroll
      for (int m = 0; m < 4; ++m)
#pragma unroll
        for (int k = 0; k < 2; ++k) At[m][k] = *reinterpret_cast<const bf16x8*>(pa + lds_byte((wr & 1) * 64 + m * 16 + fr, k * 32 + fq * 8));
#pragma unroll
      for (int n = 0; n < 4; ++n)
#pragma unroll
        for (int k = 0; k < 2; ++k) Bf[n][k] = *reinterpret_cast<const bf16x8*>(pb + lds_byte(wc * 64 + n * 16 + fr, k * 32 + fq * 8));
      if (t + 2 < nt) { const int b2 = (b == 0) ? 2 : b - 1; STAGE_ALL(b2, t + 2); WAIT_V(6); } else { WAIT_V(0); }
      asm volatile("s_waitcnt lgkmcnt(0)" ::: "memory");
      __builtin_amdgcn_sched_barrier(0);
      BAR;
      __builtin_amdgcn_sched_barrier(0);
      __builtin_amdgcn_s_setprio(1);
#pragma unroll
      for (int k = 0; k < 2; ++k)
#pragma unroll
        for (int m = 0; m < 4; ++m)
#pragma unroll
          for (int n = 0; n < 4; ++n) acc[m][n] = __builtin_amdgcn_mfma_f32_16x16x32_bf16(Bf[n][k], At[m][k], acc[m][n], 0, 0, 0);
      __builtin_amdgcn_s_setprio(0);
      __builtin_amdgcn_sched_barrier(0);
      BAR;
      __builtin_amdgcn_sched_barrier(0);
      b = (b == 2) ? 0 : b + 1;
    }
    if (hasNext) {
      STAGE_NEXT(0, 0);
      if (nt > 1) STAGE_NEXT(1, 1);
    }
    epi(acc, brow, bcol);
    if (grp == 0) BAR;
  }
  if (LOWREG) epi(acc, brow, bcol);
#undef SA
#undef SB
}

#define EPI_IDS const int tid = tid_(); const int wid = tid >> 6, lane = tid & 63, wr = wid >> 1, wc = wid & 1, fr = lane & 15, fq = lane >> 4; (void)wr; (void)wc; (void)fr; (void)fq;

struct EpiStoreBf16 {
  u16* out; int ld;
  DI void operator()(acc_t& acc, int brow, int bcol) const {
    EPI_IDS
#pragma unroll
    for (int m = 0; m < 4; ++m)
#pragma unroll
      for (int n = 0; n < 4; ++n) {
        int row = brow + wr * 64 + m * 16 + fr, col = bcol + wc * 64 + n * 16 + fq * 4;
        uint2 v = {pack2(acc[m][n][0], acc[m][n][1]), pack2(acc[m][n][2], acc[m][n][3])};
        *(uint2*)(out + (unsigned)(row * ld + col)) = v;
      }
  }
};
struct EpiSwiglu {
  u16* out;
  DI void operator()(acc_t& acc, int brow, int bcol) const {
    EPI_IDS
    const int cb = (bcol >> 7) * 64 + wc * 32;
#pragma unroll
    for (int m = 0; m < 4; ++m)
#pragma unroll
      for (int n = 0; n < 2; ++n) {
        int row = brow + wr * 64 + m * 16 + fr, col = cb + n * 16 + fq * 4;
        float r[4];
#pragma unroll
        for (int j = 0; j < 4; ++j) { float g = acc[m][n][j], u = acc[m][n + 2][j]; r[j] = g * sigmoidf_(g) * u; }
        uint2 v = {pack2(r[0], r[1]), pack2(r[2], r[3])};
        *(uint2*)(out + (unsigned)(row * DFF + col)) = v;
      }
  }
};
struct EpiResid {
  float* x; float c;
  DI void operator()(acc_t& acc, int brow, int bcol) const {
    EPI_IDS
    f32x4 v[16];
#pragma unroll
    for (int m = 0; m < 4; ++m)
#pragma unroll
      for (int n = 0; n < 4; ++n) {
        const int row = brow + wr * 64 + m * 16 + fr, col = bcol + wc * 64 + n * 16 + fq * 4;
        v[m * 4 + n] = *(const f32x4*)(x + (unsigned)(row * DM + col));
      }
    asm volatile("" : "+v"(v[0]), "+v"(v[1]), "+v"(v[2]), "+v"(v[3]), "+v"(v[4]), "+v"(v[5]), "+v"(v[6]), "+v"(v[7]));
    asm volatile("" : "+v"(v[8]), "+v"(v[9]), "+v"(v[10]), "+v"(v[11]), "+v"(v[12]), "+v"(v[13]), "+v"(v[14]), "+v"(v[15]));
#pragma unroll
    for (int m = 0; m < 4; ++m)
#pragma unroll
      for (int n = 0; n < 4; ++n) {
        const int row = brow + wr * 64 + m * 16 + fr, col = bcol + wc * 64 + n * 16 + fq * 4;
        f32x4 w = v[m * 4 + n];
        w[0] += c * acc[m][n][0]; w[1] += c * acc[m][n][1]; w[2] += c * acc[m][n][2]; w[3] += c * acc[m][n][3];
        *(f32x4*)(x + (unsigned)(row * DM + col)) = w;
      }
  }
};
struct EpiGateReg {
  unsigned* gp;
  DI void operator()(acc_t& acc, int brow, int bcol) const {
    int e = 0;
#pragma unroll
    for (int m = 0; m < 4; ++m)
#pragma unroll
      for (int n = 0; n < 4; ++n)
#pragma unroll
        for (int j = 0; j < 4; j += 2) { gp[e] = pack2(sigmoidf_(acc[m][n][j]), sigmoidf_(acc[m][n][j + 1])); ++e; }
  }
};
struct EpiMergeReg {
  const unsigned* gp; unsigned* macc;
  DI void operator()(acc_t& acc, int brow, int bcol) const {
    int e = 0;
#pragma unroll
    for (int m = 0; m < 4; ++m)
#pragma unroll
      for (int n = 0; n < 4; ++n)
#pragma unroll
        for (int j = 0; j < 4; j += 2) {
          macc[e] = pack2(lo2f(macc[e]) + lo2f(gp[e]) * acc[m][n][j], hi2f(macc[e]) + hi2f(gp[e]) * acc[m][n][j + 1]);
          ++e;
        }
  }
};

DI void tile_map(int tile, int nM, int nN, int& pm, int& pn) {
  const int WGM = 8;
  int nig = WGM * nN, gid = tile / nig, fm = gid * WGM, gsz = min(nM - fm, WGM);
  pm = fm + ((tile % nig) % gsz); pn = (tile % nig) / gsz;
}

DI int map_col(int mode, int np) {
  if (mode == 0) return np;
  if (mode == 1) { int tile = np >> 7, wc = (np >> 6) & 1, half = (np >> 5) & 1, c = np & 31; return half * DFF + tile * 64 + wc * 32 + c; }
  if (np < 2944) return np;
  if (np < 3968) return np + 32;
  if (np < 4000) return np - 1024;
  if (np < 4096) return -1;
  return np - 96;
}
DI void conv_tile(const float* __restrict__ src, u16* __restrict__ dst, int K, int Nsrc, int mode, int tile) {
  const int tid = tid_();
  extern __shared__ __attribute__((aligned(16))) char smem[];
  float* ts = (float*)smem;
  const int nkt = K / 128;
  const int nt_ = tile / nkt, kt = tile % nkt;
  const int n0 = nt_ * 32, k0 = kt * 128;
  const int ns = map_col(mode, n0);
  __syncthreads();
  {
    int n = tid & 31, k = tid >> 5;
    float v[8];
#pragma unroll
    for (int p = 0; p < 8; ++p) v[p] = (ns >= 0) ? src[(size_t)(k0 + k + 16 * p) * Nsrc + ns + n] : 0.f;
#pragma unroll
    for (int p = 0; p < 8; ++p) ts[(k + 16 * p) * 33 + n] = v[p];
  }
  __syncthreads();
  {
    int n = tid >> 4, kc = (tid & 15) * 8;
    uint4 v;
    v.x = pack2(ts[(kc + 0) * 33 + n], ts[(kc + 1) * 33 + n]);
    v.y = pack2(ts[(kc + 2) * 33 + n], ts[(kc + 3) * 33 + n]);
    v.z = pack2(ts[(kc + 4) * 33 + n], ts[(kc + 5) * 33 + n]);
    v.w = pack2(ts[(kc + 6) * 33 + n], ts[(kc + 7) * 33 + n]);
    *(uint4*)(dst + (size_t)(n0 + n) * K + k0 + kc) = v;
  }
}
DI void phase_convert(CParams& p, int layer) {
  u16* wb = (u16*)(p.ws + B_WB);
  for (int item = blockIdx.x;; item += gridDim.x) {
    int t = item;
    const float* src; u16* dst; int K, Nsrc, Ndst, mode;
#define JOB(SRC, DST, K_, NSRC_, NDST_, MODE_) { int cnt = ((NDST_) / 32) * ((K_) / 128); if (t < cnt) { src = (SRC); dst = (DST); K = (K_); Nsrc = (NSRC_); Ndst = (NDST_); mode = (MODE_); goto found; } t -= cnt; }
    JOB(p.in[2] + (size_t)layer * 1024 * 5632, wb + O_WI1, 1024, 5632, 5632, 1)
    JOB(p.in[3] + (size_t)layer * 2816 * 1024, wb + O_WO1, 2816, 1024, 1024, 0)
    JOB(p.in[5] + (size_t)layer * 1024 * 8096, wb + O_WIN, 1024, 8096, 8192, 2)
    JOB(p.in[11] + (size_t)layer * 384 * 768, wb + O_WQUP, 384, 768, 768, 0)
    JOB(p.in[13] + (size_t)layer * 256 * 1024, wb + O_WKVUP, 256, 1024, 1024, 0)
    JOB(p.in[23] + (size_t)(layer * 4 + 0) * 512 * 1024, wb + O_WBR + (size_t)0 * 1024 * 512, 512, 1024, 1024, 0)
    JOB(p.in[23] + (size_t)(layer * 4 + 1) * 512 * 1024, wb + O_WBR + (size_t)1 * 1024 * 512, 512, 1024, 1024, 0)
    JOB(p.in[23] + (size_t)(layer * 4 + 2) * 512 * 1024, wb + O_WBR + (size_t)2 * 1024 * 512, 512, 1024, 1024, 0)
    JOB(p.in[23] + (size_t)(layer * 4 + 3) * 512 * 1024, wb + O_WBR + (size_t)3 * 1024 * 512, 512, 1024, 1024, 0)
    JOB(p.in[24] + (size_t)layer * 1024 * 1024, wb + O_WOUT, 1024, 1024, 1024, 0)
    JOB(p.in[26] + (size_t)layer * 1024 * 5632, wb + O_WI2, 1024, 5632, 5632, 1)
    JOB(p.in[27] + (size_t)layer * 2816 * 1024, wb + O_WO2, 2816, 1024, 1024, 0)
#undef JOB
    break;
  found:
    (void)Ndst;
    conv_tile(src, dst, K, Nsrc, mode, t);
  }
}

DI void phase_tables(CParams& p) {
  const int tid = tid_();
  float2* gr = (float2*)(p.ws + B_TABG_R); float2* gc = (float2*)(p.ws + B_TABG_C);
  float2* mr = (float2*)(p.ws + B_TABM_R); float2* mc = (float2*)(p.ws + B_TABM_C);
  int gt = blockIdx.x * NTHR + tid, gs = gridDim.x * NTHR;
  for (int i = gt; i < 256 * 16; i += gs) { int pos = i >> 4, f = i & 15; float inv = __builtin_amdgcn_exp2f(-(float)(2 * f) / 32.f * 13.287712379549449f); float a = (float)pos * inv; gr[i] = make_float2(__cosf(a), __sinf(a)); }
  for (int i = gt; i < 64 * 16; i += gs) { int pos = i >> 4, f = i & 15; float inv = __builtin_amdgcn_exp2f(-(float)(2 * f) / 32.f * 13.287712379549449f); float a = (float)pos * inv; gc[i] = make_float2(__cosf(a), __sinf(a)); }
  for (int i = gt; i < 256 * 8; i += gs) { int pos = i >> 3, f = i & 7; float inv = __builtin_amdgcn_exp2f(-(float)(2 * f) / 16.f * 13.287712379549449f); float a = (float)pos * inv; mr[i] = make_float2(__cosf(a), __sinf(a)); }
  for (int i = gt; i < 64 * 8; i += gs) { int pos = i >> 3, f = i & 7; float inv = __builtin_amdgcn_exp2f(-(float)(2 * f) / 16.f * 13.287712379549449f); float a = (float)pos * inv; mc[i] = make_float2(__cosf(a), __sinf(a)); }
}

DI void phase_norm(const float* __restrict__ xsrc, float* __restrict__ xcopy, const float* __restrict__ g, u16* __restrict__ h) {
  const int tid = tid_();
  const int wid = tid >> 6, lane = tid & 63;
  for (int row = blockIdx.x * 8 + wid; row < T_; row += gridDim.x * 8) {
    const float4* xr = (const float4*)(xsrc + (size_t)row * DM);
    float4 v[4]; float ss = 0.f;
#pragma unroll
    for (int i = 0; i < 4; ++i) { v[i] = xr[lane + 64 * i]; ss += v[i].x * v[i].x + v[i].y * v[i].y + v[i].z * v[i].z + v[i].w * v[i].w; }
    ss = wsum_dpp(ss);
    float rs = rsqrtf(ss * (1.f / DM) + 1e-6f);
#pragma unroll
    for (int i = 0; i < 4; ++i) {
      float4 gg = ((const float4*)g)[lane + 64 * i];
      uint2 o = {pack2(v[i].x * rs * gg.x, v[i].y * rs * gg.y), pack2(v[i].z * rs * gg.z, v[i].w * rs * gg.w)};
      *(uint2*)(h + (size_t)row * DM + (lane + 64 * i) * 4) = o;
      if (xcopy) ((float4*)(xcopy + (size_t)row * DM))[lane + 64 * i] = v[i];
    }
  }
}

DI bool tile_map_xcd(int bid, int nblk, int round, int nM, int nN, int& pm, int& pn) {
  if (nblk != 256 || nM != 128 || (nN & 3)) return false;
  const int xcd = bid & 7, loc = bid >> 3, lr = loc & 7, lc = loc >> 3;
  const int ncg = nN >> 2;
  const int cg = round % ncg, rg = round / ncg;
  pm = xcd + 8 * (rg * 8 + lr); pn = cg * 4 + lc;
  return true;
}
template <class Epi>
DI void gemm_phase(const u16* A, int lda, const u16* Bt, int ldb, int K, int M, int N, Epi epi, int first, int stride) {
  const int nM = M / BM, nN = N / BN, ntile = nM * nN;
  int round = 0, pm = 0, pn = 0;
  if (first < ntile) { if (!tile_map_xcd(first, stride, 0, nM, nN, pm, pn)) tile_map(first, nM, nN, pm, pn); }
  for (int tile = first; tile < ntile; tile += stride, ++round) {
    const int nxt = tile + stride;
    const bool hasNext = nxt < ntile;
    int qm = 0, qn = 0;
    if (hasNext) { if (!tile_map_xcd(first, stride, round + 1, nM, nN, qm, qn)) tile_map(nxt, nM, nN, qm, qn); }
    gemm_tile(A, lda, Bt, ldb, K, pm * BM, pn * BN, epi, round > 0, hasNext, qm * BM, qn * BN);
    pm = qm; pn = qn;
  }
}

struct PostTok { u16 rh[10], rq[6], rk[4]; uint4 bg, cg[3], xs[3]; float2 cs; };
DI void post_load(const u16* __restrict__ u, int t, int s, int lane, const float2* tgr, const float2* tgc, PostTok& d) {
  const u16* ur = u + (size_t)t * UW;
  const int rowp = s >> 6, colp = s & 63;
  d.cs = (lane < 32) ? tgr[rowp * 16 + (lane & 15)] : tgc[colp * 16 + (lane & 15)];
#pragma unroll
  for (int hd = 0; hd < 10; ++hd) d.rh[hd] = ur[hd * 64 + lane];
#pragma unroll
  for (int k = 0; k < 6; ++k) d.rq[k] = ur[UQLAT + lane + 64 * k];
#pragma unroll
  for (int k = 0; k < 4; ++k) d.rk[k] = ur[UKVLAT + lane + 64 * k];
  const int c0 = lane * 8;
  d.bg = *(const uint4*)(ur + USC + c0);
#pragma unroll
  for (int k = 0; k < 3; ++k) {
    const int s2 = s + k - 1;
    if (s2 >= 0 && s2 < S_) {
      const u16* r2 = u + (size_t)(t + k - 1) * UW + USC;
      d.cg[k] = *(const uint4*)(r2 + 512 + c0); d.xs[k] = *(const uint4*)(r2 + 1024 + c0);
    } else { d.cg[k] = uint4{0, 0, 0, 0}; d.xs[k] = uint4{0, 0, 0, 0}; }
  }
}
DI void post_tile(CParams& p, int layer, int tile) {
  const int tid = tid_();
  extern __shared__ __attribute__((aligned(16))) char smem[];
  u16* u = (u16*)(p.ws + B_U);
  const float2* tgr = (const float2*)(p.ws + B_TABG_R); const float2* tgc = (const float2*)(p.ws + B_TABG_C);
  const int wid = tid >> 6, lane = tid & 63;
  const int tb = tile * 64;
  const int b = tb / S_, sb = tb % S_;
  const float* qn = p.in[6] + layer * 64; const float* kn = p.in[7] + layer * 64;
  const float* scw = p.in[8] + layer * 3 * 512; const float* scb = p.in[9] + layer * 512;
  const float* qan = p.in[10] + layer * 384; const float* kvan = p.in[12] + layer * 256;
  const float gq = qn[lane], gk = kn[lane];
  float qanr[6], kvanr[4], scwr[3][8], scbr[8];
#pragma unroll
  for (int k = 0; k < 6; ++k) qanr[k] = qan[lane + 64 * k];
#pragma unroll
  for (int k = 0; k < 4; ++k) kvanr[k] = kvan[lane + 64 * k];
#pragma unroll
  for (int e = 0; e < 8; ++e) { scbr[e] = scb[lane * 8 + e];
#pragma unroll
    for (int k = 0; k < 3; ++k) scwr[k][e] = scw[k * 512 + lane * 8 + e]; }
  __syncthreads();
  PostTok dA, dB;
  post_load(u, tb + wid * 8, sb + wid * 8, lane, tgr, tgc, dA);
#pragma unroll
  for (int i = 0; i < 8; ++i) {
    PostTok& d = (i & 1) ? dB : dA;
    PostTok& dn = (i & 1) ? dA : dB;
    const int tl = wid * 8 + i, t = tb + tl, s = sb + tl;
    if (i + 1 < 8) post_load(u, t + 1, s + 1, lane, tgr, tgc, dn);
    u16* ur = u + (size_t)t * UW;
    const float2 cs = d.cs;
    float xh[10], ss[12];
#pragma unroll
    for (int hd = 0; hd < 10; ++hd) { xh[hd] = bf2f(d.rh[hd]); ss[hd] = xh[hd] * xh[hd]; }
    float xq[6], xk[4];
    ss[10] = 0.f; ss[11] = 0.f;
#pragma unroll
    for (int k = 0; k < 6; ++k) { xq[k] = bf2f(d.rq[k]); ss[10] += xq[k] * xq[k]; }
#pragma unroll
    for (int k = 0; k < 4; ++k) { xk[k] = bf2f(d.rk[k]); ss[11] += xk[k] * xk[k]; }
#pragma unroll
    for (int c = 0; c < 12; ++c) ss[c] = wsum_dpp(ss[c]);
    float yh[10], prh[10];
#pragma unroll
    for (int hd = 0; hd < 10; ++hd) yh[hd] = xh[hd] * rsqrtf(ss[hd] * (1.f / 64.f) + 1e-6f) * (hd < 8 ? gq : gk);
#pragma unroll
    for (int hd = 0; hd < 10; ++hd) prh[hd] = xor16_(yh[hd], lane);
#pragma unroll
    for (int hd = 0; hd < 10; ++hd) {
      float o = yh[hd] * cs.x + ((lane & 16) ? prh[hd] : -prh[hd]) * cs.y;
      if (hd < 8) o *= 0.125f * 1.4426950408889634f;
      ur[hd * 64 + lane] = f2bf(o);
    }
    {
      float rs = rsqrtf(ss[10] * (1.f / 384.f) + 1e-6f);
#pragma unroll
      for (int k = 0; k < 6; ++k) ur[UQLAT + lane + 64 * k] = f2bf(xq[k] * rs * qanr[k]);
      float rs2 = rsqrtf(ss[11] * (1.f / 256.f) + 1e-6f);
#pragma unroll
      for (int k = 0; k < 4; ++k) ur[UKVLAT + lane + 64 * k] = f2bf(xk[k] * rs2 * kvanr[k]);
    }
    {
      const int c0 = lane * 8;
      float accv[8];
#pragma unroll
      for (int e = 0; e < 8; ++e) accv[e] = scbr[e];
#pragma unroll
      for (int k = 0; k < 3; ++k) {
        const unsigned cgs[4] = {d.cg[k].x, d.cg[k].y, d.cg[k].z, d.cg[k].w}; const unsigned xss[4] = {d.xs[k].x, d.xs[k].y, d.xs[k].z, d.xs[k].w};
#pragma unroll
        for (int e = 0; e < 4; ++e) {
          accv[2 * e] += scwr[k][2 * e] * (lo2f(cgs[e]) * lo2f(xss[e]));
          accv[2 * e + 1] += scwr[k][2 * e + 1] * (hi2f(cgs[e]) * hi2f(xss[e]));
        }
      }
      const uint4 bg = d.bg;
      uint4 o;
      o.x = pack2(lo2f(bg.x) * accv[0], hi2f(bg.x) * accv[1]);
      o.y = pack2(lo2f(bg.y) * accv[2], hi2f(bg.y) * accv[3]);
      o.z = pack2(lo2f(bg.z) * accv[4], hi2f(bg.z) * accv[5]);
      o.w = pack2(lo2f(bg.w) * accv[6], hi2f(bg.w) * accv[7]);
      *(uint4*)(ur + USC + c0) = o;
    }
  }
  {
    u16* ls = (u16*)smem;
    int tok = tid >> 3, ch = tid & 7;
    const u16* src = u + (size_t)(tb + tok) * UW + UV + ch * 16;
    uint4 a = *(const uint4*)src, c = *(const uint4*)(src + 8);
    const unsigned w[8] = {a.x, a.y, a.z, a.w, c.x, c.y, c.z, c.w};
    int pt = permkey(tok);
#pragma unroll
    for (int e = 0; e < 8; ++e) {
      ls[(ch * 16 + 2 * e) * 72 + pt] = (u16)(w[e] & 0xffff);
      ls[(ch * 16 + 2 * e + 1) * 72 + pt] = (u16)(w[e] >> 16);
    }
    __syncthreads();
    u16* vtg = (u16*)(p.ws + B_VTG);
#pragma unroll
    for (int k = 0; k < 2; ++k) {
      int idx = tid + 512 * k, row = idx >> 3, c8 = idx & 7;
      uint4 v = *(const uint4*)(ls + row * 72 + c8 * 8);
      *(uint4*)(vtg + ((size_t)(b * 2 + (row >> 6)) * 64 + (row & 63)) * S_ + sb + c8 * 8) = v;
    }
  }
}

DI void lru_phase(CParams& p, int layer, int pass, int bid, int nblk, unsigned* qctr = nullptr, volatile unsigned __attribute__((address_space(3)))* qslot = nullptr) {
  const int tid = tid_();
  extern __shared__ __attribute__((aligned(16))) char smem[];
  u16* xcb = (u16*)smem;
  float* xcf = (float*)(smem + 64 * 72 * 2);
  float* G = xcf + 64 * 64;
  float2* part = (float2*)(G + 4 * 64 * 64);
  u16* u = (u16*)(p.ws + B_U);
  const float* cw = p.in[16] + layer * 4 * 512; const float* cb = p.in[17] + layer * 512;
  const float* lam = p.in[22] + (size_t)layer * 2 * 512;
  const int wid = tid >> 6, lane = tid & 63;
  const int mi = wid >> 1, dh = wid & 1, r = lane & 31, hh = lane >> 5, mdir = mi >> 1;
  const int ctok = tid >> 3, ccg = (tid & 7) * 8;
  const int ec = tid & 63;
  const int sdir = tid >> 8, ssub = (tid >> 6) & 3;
  int nbPrev = -1;
  bf16x8 wf[4]; float bs = 0.f, sp0 = 0.f, sp1 = 0.f;
  float cwr[4][8], cbr[8];
  const int qcls = (bid >> 3) & 7;
#pragma unroll 1
  for (int item = bid;; item += nblk) {
    if (qctr) {
      if (tid == 0) *qslot = atomicAdd(qctr + qcls, 1u);
      __syncthreads();
      const unsigned tk = *qslot;
      if (tk >= 512u) break;
      item = (int)tk * 8 + qcls;
    } else if (item >= 4096) break;
    const int nb = item & 7, j = (item >> 3) & 255, b = item >> 11;
    const int c0 = nb * 64, s0 = j * 64;
    if (nb != nbPrev) {
      nbPrev = nb;
      const float* W = ((mi & 1) ? p.in[20] : p.in[18]) + ((size_t)((layer * 2 + mdir) * 8 + nb)) * 64 * 64;
      const float* bias = ((mi & 1) ? p.in[21] : p.in[19]) + (size_t)(layer * 2 + mdir) * 512 + c0;
#pragma unroll
      for (int ks = 0; ks < 4; ++ks) {
        unsigned bw[4];
#pragma unroll
        for (int jj = 0; jj < 4; ++jj) {
          float w0 = W[(16 * ks + 8 * hh + 2 * jj) * 64 + 32 * dh + r];
          float w1 = W[(16 * ks + 8 * hh + 2 * jj + 1) * 64 + 32 * dh + r];
          bw[jj] = pack2(w0, w1);
        }
        uint4 bq = {bw[0], bw[1], bw[2], bw[3]};
        wf[ks] = __builtin_bit_cast(bf16x8, bq);
      }
      bs = bias[32 * dh + r];
      sp0 = softplus_neg(lam[c0 + ec]); sp1 = softplus_neg(lam[512 + c0 + ec]);
#pragma unroll
      for (int e = 0; e < 8; ++e) {
        cbr[e] = cb[c0 + ccg + e];
#pragma unroll
        for (int k = 0; k < 4; ++k) cwr[k][e] = cw[k * 512 + c0 + ccg + e];
      }
    }
    __syncthreads();
    {
      float a[8];
#pragma unroll
      for (int e = 0; e < 8; ++e) a[e] = cbr[e];
#pragma unroll
      for (int k = 0; k < 4; ++k) {
        int s2 = s0 + ctok + k - 2;
        if (s2 >= 0 && s2 < S_) {
          uint4 xv = *(const uint4*)(u + (size_t)(b * S_ + s2) * UW + ULRU + 512 + c0 + ccg);
          const unsigned w[4] = {xv.x, xv.y, xv.z, xv.w};
#pragma unroll
          for (int e = 0; e < 4; ++e) {
            a[2 * e] += cwr[k][2 * e] * lo2f(w[e]);
            a[2 * e + 1] += cwr[k][2 * e + 1] * hi2f(w[e]);
          }
        }
      }
#pragma unroll
      for (int e = 0; e < 8; ++e) xcf[ctok * 64 + ccg + e] = a[e];
      uint4 o = {pack2(a[0], a[1]), pack2(a[2], a[3]), pack2(a[4], a[5]), pack2(a[6], a[7])};
      *(uint4*)(xcb + ctok * 72 + ccg) = o;
    }
    u16* gp = u + (size_t)(b * S_ + s0 + ctok) * UW + ULRU + c0 + ccg;
    uint4 gv = {0, 0, 0, 0};
    if (pass == 3) gv = *(const uint4*)gp;
    __syncthreads();
    {
      f32x16 acc0, acc1;
#pragma unroll
      for (int i = 0; i < 16; ++i) { acc0[i] = 0.f; acc1[i] = 0.f; }
#pragma unroll
      for (int ks = 0; ks < 4; ++ks) {
        bf16x8 a0 = *(const bf16x8*)(xcb + (r)*72 + 16 * ks + 8 * hh);
        bf16x8 a1 = *(const bf16x8*)(xcb + (32 + r) * 72 + 16 * ks + 8 * hh);
        acc0 = __builtin_amdgcn_mfma_f32_32x32x16_bf16(a0, wf[ks], acc0, 0, 0, 0);
        acc1 = __builtin_amdgcn_mfma_f32_32x32x16_bf16(a1, wf[ks], acc1, 0, 0, 0);
      }
#pragma unroll
      for (int i = 0; i < 16; ++i) {
        int row = (i & 3) + 8 * (i >> 2) + 4 * hh;
        G[(mi * 64 + row) * 64 + 32 * dh + r] = sigmoidf_(acc0[i] + bs);
        G[(mi * 64 + 32 + row) * 64 + 32 * dh + r] = sigmoidf_(acc1[i] + bs);
      }
    }
    __syncthreads();
    {
      const float* Ga = G + (2 * sdir) * 4096; float* Gb = G + (2 * sdir + 1) * 4096;
      const int tb = ssub * 16;
      const float sp = sdir ? sp1 : sp0;
      float av[16], bv[16];
#pragma unroll
      for (int k = 0; k < 16; ++k) {
        const int t = tb + (sdir ? 15 - k : k);
        const float rr = Ga[t * 64 + ec], ii = Gb[t * 64 + ec];
        const float la = -8.f * rr * sp;
        av[k] = __expf(la);
        bv[k] = __builtin_amdgcn_sqrtf(fmaxf(1.f - av[k] * av[k], 0.f)) * ii * xcf[t * 64 + ec];
      }
      float hv = 0.f, P = 1.f;
#pragma unroll
      for (int k = 0; k < 16; ++k) { hv = av[k] * hv + bv[k]; P *= av[k]; }
      part[(sdir * 4 + ssub) * 64 + ec] = make_float2(P, hv);
      __syncthreads();
      const size_t sidx = ((size_t)((b * 2 + sdir) * 256 + j)) * 512 + c0 + ec;
      if (pass == 1) {
        if (ssub == 0) {
          float Pt = 1.f, ht = 0.f;
#pragma unroll
          for (int q = 0; q < 4; ++q) { float2 pq = part[(sdir * 4 + (sdir ? 3 - q : q)) * 64 + ec]; ht = pq.x * ht + pq.y; Pt *= pq.x; }
          ((float2*)(p.ws + B_SUMM))[sidx] = make_float2(Pt, ht);
        }
      } else {
        float cin = ((const float*)(p.ws + B_CARRY))[sidx];
#pragma unroll
        for (int q = 0; q < 3; ++q) {
          const int sq = sdir ? 3 - q : q;
          const bool before = sdir ? (sq > ssub) : (sq < ssub);
          float2 pq = part[(sdir * 4 + sq) * 64 + ec];
          if (before) cin = pq.x * cin + pq.y;
        }
        hv = cin;
#pragma unroll
        for (int k = 0; k < 16; ++k) { const int t = tb + (sdir ? 15 - k : k); hv = av[k] * hv + bv[k]; Gb[t * 64 + ec] = hv; }
      }
    }
    if (pass == 3) {
      __syncthreads();
      const unsigned w[4] = {gv.x, gv.y, gv.z, gv.w};
      float o[8];
#pragma unroll
      for (int e = 0; e < 8; ++e) {
        float g = (e & 1) ? hi2f(w[e >> 1]) : lo2f(w[e >> 1]);
        float ge = 0.5f * g * (1.f + tanh_(0.7978845608028654f * (g + 0.044715f * g * g * g)));
        o[e] = ge * (G[(1 * 64 + ctok) * 64 + ccg + e] + G[(3 * 64 + ctok) * 64 + ccg + e]);
      }
      uint4 ov = {pack2(o[0], o[1]), pack2(o[2], o[3]), pack2(o[4], o[5]), pack2(o[6], o[7])};
      *(uint4*)gp = ov;
    }
  }
}
DI void lru_carry(CParams& p, int blk) {
  const int tid = tid_();
  int id = blk * NTHR + tid;
  int c = id & 511, dir = (id >> 9) & 1, b = id >> 10;
  const float2* __restrict__ sm = (const float2*)(p.ws + B_SUMM) + (size_t)(b * 2 + dir) * 256 * 512 + c;
  float* __restrict__ cr = (float*)(p.ws + B_CARRY) + (size_t)(b * 2 + dir) * 256 * 512 + c;
  float cin = 0.f;
#pragma unroll 1
  for (int k0 = 0; k0 < 256; k0 += 32) {
    float2 ab[32];
#pragma unroll
    for (int i = 0; i < 32; ++i) { const int j = dir ? 255 - (k0 + i) : (k0 + i); ab[i] = sm[(size_t)j * 512]; }
#pragma unroll
    for (int i = 0; i < 32; ++i) {
      const int j = dir ? 255 - (k0 + i) : (k0 + i);
      cr[(size_t)j * 512] = cin;
      cin = ab[i].x * cin + ab[i].y;
    }
  }
}

template <int D>
DI void attn_tile(const u16* __restrict__ Qp, int ldq, const u16* __restrict__ Kp, int ldk, const u16* __restrict__ Vt,
                  u16* __restrict__ Op, int ldo, int q0, float cs, float mc) {
  const int tid = tid_();
  extern __shared__ __attribute__((aligned(16))) char smem[];
  constexpr int KS = D * 2 + 16, VS = 144, KB = 64 * KS, VB = 64 * VS, BUF = KB + VB;
  constexpr int NKS = D / 16, CPR = D / 8;
  constexpr int NIT = S_ / 64;
  const int wid = tid >> 6, lane = tid & 63, r = lane & 31, hh = lane >> 5, grp = wid >> 2;
  __syncthreads();
  bf16x8 qf[NKS];
  {
    const u16* qr = Qp + (size_t)(q0 + wid * 32 + r) * ldq + 8 * hh;
#pragma unroll
    for (int ks = 0; ks < NKS; ++ks) qf[ks] = *(const bf16x8*)(qr + 16 * ks);
  }
  f32x16 o0, o1, s0, s1;
#pragma unroll
  for (int i = 0; i < 16; ++i) { o0[i] = 0.f; o1[i] = 0.f; }
  float lsum0 = 0.f, lsum1 = 0.f;
  uint4 kr0, kr1, vr;
  const int vrow = tid >> 3, vch = tid & 7;
  int krow0, kch0, krow1 = 0, kch1 = 0;
  if (D == 64) { krow0 = tid >> 3; kch0 = tid & 7; }
  else { krow0 = tid / CPR; kch0 = tid % CPR; int i2 = tid + 512; krow1 = i2 / CPR; kch1 = i2 % CPR; }
  const bool k2 = (D == 96) && (tid < 256);
  kr1 = uint4{0, 0, 0, 0};
#define LOADT(key0) do { kr0 = *(const uint4*)(Kp + (size_t)((key0) + krow0) * ldk + kch0 * 8); \
    if (k2) kr1 = *(const uint4*)(Kp + (size_t)((key0) + krow1) * ldk + kch1 * 8); \
    vr = *(const uint4*)(Vt + (size_t)vrow * S_ + (key0) + vch * 8); } while (0)
#define STORET(bufi) do { char* bb = smem + (bufi) * BUF; *(uint4*)(bb + krow0 * KS + kch0 * 16) = kr0; \
    if (k2) *(uint4*)(bb + krow1 * KS + kch1 * 16) = kr1; \
    *(uint4*)(bb + KB + vrow * VS + vch * 16) = vr; } while (0)
#define LOADKF(bufi) do { const char* kb_ = smem + (bufi) * BUF + r * KS + 16 * hh; \
    _Pragma("unroll") for (int ks = 0; ks < NKS; ++ks) { kf0[ks] = *(const bf16x8*)(kb_ + 32 * ks); kf1[ks] = *(const bf16x8*)(kb_ + 32 * KS + 32 * ks); } } while (0)
#define SMMA() do { const f32x16 z_ = {0.f, 0.f, 0.f, 0.f, 0.f, 0.f, 0.f, 0.f, 0.f, 0.f, 0.f, 0.f, 0.f, 0.f, 0.f, 0.f}; \
    s0 = __builtin_amdgcn_mfma_f32_32x32x16_bf16(kf0[0], qf[0], z_, 0, 0, 0); \
    s1 = __builtin_amdgcn_mfma_f32_32x32x16_bf16(kf1[0], qf[0], z_, 0, 0, 0); \
    _Pragma("unroll") for (int ks = 1; ks < NKS; ++ks) { s0 = __builtin_amdgcn_mfma_f32_32x32x16_bf16(kf0[ks], qf[ks], s0, 0, 0, 0); \
      s1 = __builtin_amdgcn_mfma_f32_32x32x16_bf16(kf1[ks], qf[ks], s1, 0, 0, 0); } } while (0)
#define BARX do { __builtin_amdgcn_sched_barrier(0); asm volatile("s_waitcnt lgkmcnt(0)" ::: "memory"); __builtin_amdgcn_s_barrier(); __builtin_amdgcn_sched_barrier(0); } while (0)
  bf16x8 kf0[NKS], kf1[NKS];
  LOADT(0); STORET(0);
  LOADT(64); STORET(1);
  __syncthreads();
  LOADT(128);
  LOADKF(0);
  SMMA();
  if (grp == 1) BARX;
#pragma unroll 1
  for (int it = 0; it < NIT; ++it) {
    bf16x8 pf[2][2];
    if (mc != 0.f) {
#pragma unroll
      for (int i = 0; i < 16; ++i) { s0[i] -= mc; s1[i] -= mc; }
    }
#pragma unroll
    for (int i = 0; i < 16; ++i) {
      s0[i] = __builtin_amdgcn_exp2f(s0[i]); s1[i] = __builtin_amdgcn_exp2f(s1[i]);
      lsum0 += s0[i]; lsum1 += s1[i];
    }
#pragma unroll
    for (int st = 0; st < 2; ++st) {
      uint4 a = {pack2(s0[8 * st], s0[8 * st + 1]), pack2(s0[8 * st + 2], s0[8 * st + 3]), pack2(s0[8 * st + 4], s0[8 * st + 5]), pack2(s0[8 * st + 6], s0[8 * st + 7])};
      uint4 c = {pack2(s1[8 * st], s1[8 * st + 1]), pack2(s1[8 * st + 2], s1[8 * st + 3]), pack2(s1[8 * st + 4], s1[8 * st + 5]), pack2(s1[8 * st + 6], s1[8 * st + 7])};
      pf[0][st] = __builtin_bit_cast(bf16x8, a); pf[1][st] = __builtin_bit_cast(bf16x8, c);
    }
    if (it + 2 < NIT) STORET((it + 2) & 3);
    if (it + 3 < NIT) LOADT((it + 3) * 64);
    if (it + 1 < NIT) LOADKF((it + 1) & 3);
    BARX;
    __builtin_amdgcn_s_setprio(1);
    {
      const char* vb = smem + (it & 3) * BUF + KB + r * VS + 16 * hh;
      bf16x8 v0[2], v1[2];
#pragma unroll
      for (int q = 0; q < 2; ++q) { v0[q] = *(const bf16x8*)(vb + 32 * q); v1[q] = *(const bf16x8*)(vb + 32 * VS + 32 * q); }
      if (it + 1 < NIT) SMMA();
#pragma unroll
      for (int q = 0; q < 2; ++q) {
        o0 = __builtin_amdgcn_mfma_f32_32x32x16_bf16(v0[q], pf[0][q], o0, 0, 0, 0);
        o1 = __builtin_amdgcn_mfma_f32_32x32x16_bf16(v1[q], pf[0][q], o1, 0, 0, 0);
      }
#pragma unroll
      for (int q = 0; q < 2; ++q) { v0[q] = *(const bf16x8*)(vb + 64 + 32 * q); v1[q] = *(const bf16x8*)(vb + 32 * VS + 64 + 32 * q); }
#pragma unroll
      for (int q = 0; q < 2; ++q) {
        o0 = __builtin_amdgcn_mfma_f32_32x32x16_bf16(v0[q], pf[1][q], o0, 0, 0, 0);
        o1 = __builtin_amdgcn_mfma_f32_32x32x16_bf16(v1[q], pf[1][q], o1, 0, 0, 0);
      }
    }
    __builtin_amdgcn_s_setprio(0);
    BARX;
  }
  if (grp == 0) BARX;
#undef LOADT
#undef STORET
#undef LOADKF
#undef SMMA
#undef BARX
  float lsum = lsum0 + lsum1;
  lsum += shx(lsum, 32, lane);
  const float inv = rcp_(lsum);
  u16* orow = Op + (size_t)(q0 + wid * 32 + r) * ldo;
#pragma unroll
  for (int g = 0; g < 4; ++g) {
    uint2 a = {pack2(o0[4 * g] * inv, o0[4 * g + 1] * inv), pack2(o0[4 * g + 2] * inv, o0[4 * g + 3] * inv)};
    uint2 c = {pack2(o1[4 * g] * inv, o1[4 * g + 1] * inv), pack2(o1[4 * g + 2] * inv, o1[4 * g + 3] * inv)};
    *(uint2*)(orow + 8 * g + 4 * hh) = a;
    *(uint2*)(orow + 32 + 8 * g + 4 * hh) = c;
  }
}

DI float gain_absmax(const float* g, int n) {
  float m = 0.f;
  for (int i = 0; i < n; ++i) m = fmaxf(m, fabsf(g[i]));
  return m;
}

struct MlaTok { unsigned qw[8], kw[8]; float2 c0, c1; };
DI void mla_load(const u16* __restrict__ u, const u16* __restrict__ qm, const u16* __restrict__ kvm, int t, int s, int lane, int e0, bool rl,
                 const float2* tmr, const float2* tmc, MlaTok& d) {
  const int rowp = s >> 6, colp = s & 63;
  d.c0 = float2{1.f, 0.f}; d.c1 = float2{1.f, 0.f};
  if (rl) {
    if (e0 < 16) { d.c0 = tmr[rowp * 8 + (e0 & 7)]; d.c1 = tmr[rowp * 8 + ((e0 + 1) & 7)]; }
    else { d.c0 = tmc[colp * 8 + (e0 & 7)]; d.c1 = tmc[colp * 8 + ((e0 + 1) & 7)]; }
  }
  const unsigned kro = rl ? *(const unsigned*)(u + (size_t)t * UW + UKROPE + e0) : 0u;
#pragma unroll
  for (int hd = 0; hd < 8; ++hd) {
    d.qw[hd] = (lane < 48) ? *(const unsigned*)(qm + (size_t)t * 768 + hd * 96 + 2 * lane) : 0u;
    d.kw[hd] = (lane < 32) ? *(const unsigned*)(kvm + (size_t)t * 1024 + hd * 128 + 2 * lane) : kro;
  }
}
DI void mla_post_tile(CParams& p, int layer, int tile) {
  const int tid = tid_();
  extern __shared__ __attribute__((aligned(16))) char smem[];
  u16* ls = (u16*)smem;
  u16* u = (u16*)(p.ws + B_U); u16* qm = (u16*)(p.ws + B_QM); u16* kvm = (u16*)(p.ws + B_KVM); u16* vtm = (u16*)(p.ws + B_VTM);
  const float2* tmr = (const float2*)(p.ws + B_TABM_R); const float2* tmc = (const float2*)(p.ws + B_TABM_C);
  const float* qn = p.in[14] + layer * 96; const float* kn = p.in[15] + layer * 96;
  const int wid = tid >> 6, lane = tid & 63;
  const int tb = tile * 64, b = tb / S_, sb = tb % S_;
  __syncthreads();
#pragma unroll
  for (int k = 0; k < 8; ++k) {
    int idx = tid + 512 * k, tok = idx >> 6, cc = idx & 63, hd = cc >> 3, dvc = (cc & 7) * 8;
    uint4 v = *(const uint4*)(kvm + (size_t)(tb + tok) * 1024 + hd * 128 + 64 + dvc);
    const unsigned w[4] = {v.x, v.y, v.z, v.w};
    int pt = permkey(tok);
#pragma unroll
    for (int e = 0; e < 4; ++e) {
      ls[(hd * 64 + dvc + 2 * e) * 72 + pt] = (u16)(w[e] & 0xffff);
      ls[(hd * 64 + dvc + 2 * e + 1) * 72 + pt] = (u16)(w[e] >> 16);
    }
  }
  __syncthreads();
  const int e0 = 2 * (lane - 32);
  const bool rl = lane >= 32 && lane < 48;
  float gq0 = 0.f, gq1 = 0.f, gk0 = 0.f, gk1 = 0.f;
  if (lane < 48) { gq0 = qn[2 * lane]; gq1 = qn[2 * lane + 1]; gk0 = kn[2 * lane]; gk1 = kn[2 * lane + 1]; }
  MlaTok mA, mB;
  mla_load(u, qm, kvm, tb + wid * 8, sb + wid * 8, lane, e0, rl, tmr, tmc, mA);
#pragma unroll
  for (int i = 0; i < 8; ++i) {
    MlaTok& d = (i & 1) ? mB : mA;
    MlaTok& dn = (i & 1) ? mA : mB;
    const int tl = wid * 8 + i, t = tb + tl;
    if (i + 1 < 8) mla_load(u, qm, kvm, t + 1, sb + tl + 1, lane, e0, rl, tmr, tmc, dn);
    const float2 c0 = d.c0, c1 = d.c1;
    float ss[16];
#pragma unroll
    for (int hd = 0; hd < 8; ++hd) {
      float a0 = lo2f(d.qw[hd]), a1 = hi2f(d.qw[hd]), b0 = lo2f(d.kw[hd]), b1 = hi2f(d.kw[hd]);
      ss[hd] = a0 * a0 + a1 * a1; ss[8 + hd] = b0 * b0 + b1 * b1;
    }
#pragma unroll
    for (int c = 0; c < 16; ++c) ss[c] = wsum_dpp(ss[c]);
    const float qsc = (1.f / 9.797958971132712f) * 1.4426950408889634f;
    const bool up = (e0 & 8) != 0;
#pragma unroll
    for (int hd = 0; hd < 8; ++hd) {
      {
        float rs = rsqrtf(ss[hd] * (1.f / 96.f) + 1e-6f);
        float y0 = lo2f(d.qw[hd]) * rs * gq0, y1 = hi2f(d.qw[hd]) * rs * gq1;
        float p0 = xor4_(y0), p1 = xor4_(y1);
        if (rl) { y0 = y0 * c0.x + (up ? p0 : -p0) * c0.y; y1 = y1 * c1.x + (up ? p1 : -p1) * c1.y; }
        if (lane < 48) *(unsigned*)(qm + (size_t)t * 768 + hd * 96 + 2 * lane) = pack2(y0 * qsc, y1 * qsc);
      }
      {
        float rs = rsqrtf(ss[8 + hd] * (1.f / 96.f) + 1e-6f);
        float y0 = lo2f(d.kw[hd]) * rs * gk0, y1 = hi2f(d.kw[hd]) * rs * gk1;
        float p0 = xor4_(y0), p1 = xor4_(y1);
        if (rl) { y0 = y0 * c0.x + (up ? p0 : -p0) * c0.y; y1 = y1 * c1.x + (up ? p1 : -p1) * c1.y; }
        if (lane < 48) *(unsigned*)(kvm + (size_t)t * 1024 + hd * 128 + 2 * lane) = pack2(y0, y1);
      }
    }
  }
#pragma unroll
  for (int k = 0; k < 8; ++k) {
    int idx = tid + 512 * k, row = idx >> 3, c8 = idx & 7;
    uint4 v = *(const uint4*)(ls + row * 72 + c8 * 8);
    *(uint4*)(vtm + ((size_t)(b * 8 + (row >> 6)) * 64 + (row & 63)) * S_ + sb + c8 * 8) = v;
  }
}


#define XB_TMO      128
#define XB_XCNT(j)  (256  + 64 * (j))
#define XB_XSUB(j)  (1280 + 64 * (j))
#define XB_XGEN(j)  (2304 + 64 * (j))
#define XB_TOP      3328
#define XB_TOPGEN   3392
#define XB_SPIN_CAP (1u << 24)
#define LAS __attribute__((address_space(3)))
DI unsigned xb_ld(unsigned* p) { return __hip_atomic_load(p, __ATOMIC_RELAXED, __HIP_MEMORY_SCOPE_AGENT); }
DI unsigned xb_add(unsigned* p, unsigned v) { return __hip_atomic_fetch_add(p, v, __ATOMIC_RELAXED, __HIP_MEMORY_SCOPE_AGENT); }
DI unsigned xb_xcc_id() { return (unsigned)__builtin_amdgcn_s_getreg((3 << 11) | 20) & 0xFu; }
#define XB_SPIN(cond, bar) do { unsigned _sp = 0; while (cond) { __builtin_amdgcn_s_sleep(1); \
    if ((++_sp & 255u) == 0u) { if (xb_ld(&(bar)[XB_TMO])) break; if (_sp > XB_SPIN_CAP) { atomicAdd(&(bar)[XB_TMO], 1u); break; } } } } while (0)
struct XcdBarrier { unsigned* bar; unsigned x; volatile LAS unsigned* st; };
DI XcdBarrier xcd_barrier_post(unsigned* bar, volatile LAS unsigned* st) {
  XcdBarrier b; b.bar = bar; b.x = xb_xcc_id(); b.st = st;
  if (threadIdx.x == 0) (void)xb_add(&bar[XB_XCNT(b.x)], 1u);
  return b;
}
DI void xcd_barrier_complete(unsigned* bar, unsigned x, unsigned& nloc, unsigned& nx) {
  const unsigned G = gridDim.x * gridDim.y * gridDim.z;
  unsigned sum, cnt, mine, sp = 0u;
  for (;;) {
    sum = 0u; cnt = 0u; mine = 0u;
#pragma unroll
    for (unsigned j = 0; j < 16; ++j) { const unsigned c = xb_ld(&bar[XB_XCNT(j)]); sum += c; cnt += (c > 0u) ? 1u : 0u; mine = (j == x) ? c : mine; }
    if (sum == G) break;
    __builtin_amdgcn_s_sleep(1);
    if ((++sp & 255u) == 0u) { if (xb_ld(&bar[XB_TMO])) break; if (sp > XB_SPIN_CAP) { atomicAdd(&bar[XB_TMO], 1u); break; } }
  }
  nloc = mine > 0u ? mine : 1u; nx = cnt > 0u ? cnt : 1u;
}
DI void xcd_barrier(const XcdBarrier& b) {
  asm volatile("s_waitcnt vmcnt(0)" ::: "memory");
  __syncthreads();
  if (threadIdx.x == 0) {
    unsigned* bar = b.bar;
    __builtin_amdgcn_s_waitcnt(0);
    unsigned nloc = b.st[0], nx = b.st[1];
    if (nloc == 0u) { xcd_barrier_complete(bar, b.x, nloc, nx); b.st[0] = nloc; b.st[1] = nx; }
    const unsigned old = xb_add(&bar[XB_XSUB(b.x)], 1u);
    const unsigned gen = old / nloc;
    if (old + 1u == (gen + 1u) * nloc) {
      __builtin_amdgcn_fence(__ATOMIC_RELEASE, "agent");
      asm volatile("s_waitcnt vmcnt(0)" ::: "memory");
      const unsigned og = xb_add(&bar[XB_TOP], 1u);
      const unsigned tg = og / nx;
      if (og + 1u == (tg + 1u) * nx) xb_add(&bar[XB_TOPGEN], 1u);
      else XB_SPIN(xb_ld(&bar[XB_TOPGEN]) == tg, bar);
      __builtin_amdgcn_fence(__ATOMIC_ACQUIRE, "agent");
      xb_add(&bar[XB_XGEN(b.x)], 1u);
      asm volatile("s_waitcnt vmcnt(0)" ::: "memory");
    } else {
      XB_SPIN(xb_ld(&bar[XB_XGEN(b.x)]) == gen, bar);
      __builtin_amdgcn_fence(__ATOMIC_ACQUIRE, "agent");
      asm volatile("s_waitcnt vmcnt(0)" ::: "memory");
    }
  }
  __syncthreads();
}

__global__ void __launch_bounds__(NTHR) fwd_megakernel(Params p_unused) {
  cg::grid_group grid = cg::this_grid();
  __shared__ uint4 xb_words;
  if (threadIdx.x == 0) xb_words = make_uint4(0u, 0u, 0u, 0u);
  __syncthreads();
  XcdBarrier xb = xcd_barrier_post((unsigned*)(((CParams*)__builtin_amdgcn_kernarg_segment_ptr())->ws + B_BAR), (volatile LAS unsigned*)&xb_words);
  if (gridDim.x == 0x7fffffffu) grid.sync();
  const float LOG2E = 1.4426950408889634f;
  constexpr int NPH = 14;
#pragma unroll 1
  for (int step = 0; step < NL * NPH; ++step) {
    int layer = step / NPH; const int ph = step % NPH;
    asm volatile("" : "+s"(layer));
    int bid = blockIdx.x, nblk = gridDim.x;
    asm volatile("" : "+s"(bid)); asm volatile("" : "+s"(nblk));
    CParams* pp = (CParams*)__builtin_amdgcn_kernarg_segment_ptr();
    asm volatile("" : "+s"(pp));
    CParams& p = *pp;
    u16* wb = (u16*)(p.ws + B_WB);
    u16* h = (u16*)(p.ws + B_H);
    u16* u = (u16*)(p.ws + B_U);
    float* x = p.out;
    switch (ph) {
      case 0: {
        if (layer == 0) phase_tables(p);
        phase_convert(p, layer);
        phase_norm(layer == 0 ? p.in[0] : x, layer == 0 ? x : nullptr, p.in[1] + layer * DM, h);
      } break;
      case 1: gemm_phase(h, DM, wb + O_WI1, DM, DM, T_, 2 * DFF, EpiSwiglu{u}, bid, nblk); break;
      case 2: gemm_phase(u, DFF, wb + O_WO1, DFF, DFF, T_, DM, EpiResid{x, 0.5f}, bid, nblk); break;
      case 3: phase_norm(x, nullptr, p.in[4] + layer * DM, h); break;
      case 4: gemm_phase(h, DM, wb + O_WIN, DM, DM, T_, UW, EpiStoreBf16{u, UW}, bid, nblk); break;
      case 5: {
        for (int it = bid; it < 512; it += nblk) post_tile(p, layer, it);
        lru_phase(p, layer, 1, bid, nblk);
      } break;
      case 6: {
        u16* qm = (u16*)(p.ws + B_QM); u16* kvm = (u16*)(p.ws + B_KVM); u16* vtg = (u16*)(p.ws + B_VTG);
        if (bid < 4) lru_carry(p, bid);
        float mcg = 8.f * gain_absmax(p.in[6] + layer * 64, 64) * gain_absmax(p.in[7] + layer * 64, 64) * LOG2E;
        if (mcg < 60.f) mcg = 0.f;
        const float csg = 0.125f * LOG2E;
        for (int it = bid; it < 1024; it += nblk) {
          int g = it & 3, qt = (it >> 2) & 63, kvh = (it >> 8) & 1, b = it >> 9;
          int hq = kvh * 4 + g;
          attn_tile<64>(u + (size_t)b * S_ * UW + UQ + hq * 64, UW, u + (size_t)b * S_ * UW + UK + kvh * 64, UW,
                        vtg + (size_t)(b * 2 + kvh) * 64 * S_, u + (size_t)b * S_ * UW + UQ + hq * 64, UW, qt * 256, csg, mcg);
        }
        {
          unsigned* qc = (unsigned*)(p.ws + B_BAR) + 1 + layer * 9 + 8;
          volatile LAS unsigned* qslot = (volatile LAS unsigned*)&xb_words.z;
          for (;;) {
            if (threadIdx.x == 0) *qslot = atomicAdd(qc, 1u);
            __syncthreads();
            const int tk = (int)*qslot;
            if (tk >= 768 + 1024) break;
            if (tk < 768) {
              int pm, pn; tile_map(tk, 128, 6, pm, pn);
              gemm_tile(u + UQLAT, UW, wb + O_WQUP, 384, 384, pm * BM, pn * BN, EpiStoreBf16{qm, 768});
            } else {
              int pm, pn; tile_map(tk - 768, 128, 8, pm, pn);
              gemm_tile(u + UKVLAT, UW, wb + O_WKVUP, 256, 256, pm * BM, pn * BN, EpiStoreBf16{kvm, 1024});
            }
          }
        }
      } break;
      case 7: {
        for (int it = bid; it < 512; it += nblk) mla_post_tile(p, layer, it);
      } break;
      case 8: {
        u16* qm = (u16*)(p.ws + B_QM); u16* kvm = (u16*)(p.ws + B_KVM); u16* vtm = (u16*)(p.ws + B_VTM);
        const float sq96 = 9.797958971132712f;
        float mcm = sq96 * gain_absmax(p.in[14] + layer * 96, 96) * gain_absmax(p.in[15] + layer * 96, 96) * LOG2E;
        if (mcm < 60.f) mcm = 0.f;
        const float csm = (1.f / sq96) * LOG2E;
        for (int it = bid; it < 1024; it += nblk) {
          int qt = it & 63, hd = (it >> 6) & 7, b = it >> 9;
          attn_tile<96>(qm + (size_t)b * S_ * 768 + hd * 96, 768, kvm + (size_t)b * S_ * 1024 + hd * 128, 1024,
                        vtm + (size_t)(b * 8 + hd) * 64 * S_, u + (size_t)b * S_ * UW + UQLAT + hd * 64, UW, qt * 256, csm, mcm);
        }
        lru_phase(p, layer, 3, bid, nblk, (unsigned*)(p.ws + B_BAR) + 1 + layer * 9, (volatile LAS unsigned*)&xb_words.z);
      } break;
      case 9: {
        u16* merged = (u16*)(p.ws + B_MERGED);
        int round9 = 0;
        for (int tile = bid; tile < 128 * 8; tile += nblk, ++round9) {
          int pm, pn;
          if (!tile_map_xcd(bid, nblk, round9, 128, 8, pm, pn)) tile_map(tile, 128, 8, pm, pn);
          unsigned macc[32];
#pragma unroll
          for (int e = 0; e < 32; ++e) macc[e] = 0u;
#pragma unroll 1
          for (int n = 0; n < 4; ++n) {
            const int brc = (n == 0) ? UQ : (n == 1) ? USC : (n == 2) ? UQLAT : ULRU;
            unsigned gp[32];
            gemm_tile<false>(h, DM, wb + O_WIN + (size_t)(4096 + n * 1024) * DM, DM, DM, pm * BM, pn * BN, EpiGateReg{gp});
            gemm_tile<false>(u + brc, UW, wb + O_WBR + (size_t)n * 1024 * 512, 512, 512, pm * BM, pn * BN, EpiMergeReg{gp, macc});
          }
          {
            const int tid = tid_();
            const int wid = tid >> 6, lane = tid & 63, wr = wid >> 1, wc = wid & 1, fr = lane & 15, fq = lane >> 4;
#pragma unroll
            for (int m = 0; m < 4; ++m)
#pragma unroll
              for (int n = 0; n < 4; ++n) {
                const int e = (m * 4 + n) * 2;
                int row = pm * BM + wr * 64 + m * 16 + fr, col = pn * BN + wc * 64 + n * 16 + fq * 4;
                uint2 v = {macc[e], macc[e + 1]};
                *(uint2*)(merged + (unsigned)(row * DM + col)) = v;
              }
          }
        }
      } break;
      case 10: gemm_phase((u16*)(p.ws + B_MERGED), DM, wb + O_WOUT, DM, DM, T_, DM, EpiResid{x, 1.0f}, bid, nblk); break;
      case 11: phase_norm(x, nullptr, p.in[25] + layer * DM, h); break;
      case 12: gemm_phase(h, DM, wb + O_WI2, DM, DM, T_, 2 * DFF, EpiSwiglu{u}, bid, nblk); break;
      case 13: gemm_phase(u, DFF, wb + O_WO2, DFF, DFF, T_, DM, EpiResid{x, 0.5f}, bid, nblk); break;
    }
    if (step + 1 < NL * NPH) xcd_barrier(xb);
  }
}

constexpr size_t kDynLds = 147456;

extern "C" void kernel_launch(void* const* d_in, const int* in_sizes, int n_in, void* d_out, int out_size, void* d_ws, size_t ws_size,
                              hipStream_t stream) {
  static int grid_blocks = 0;
  if (!grid_blocks) {
    int dev = 0, cus = 0, per_cu = 0;
    hipGetDevice(&dev);
    hipDeviceGetAttribute(&cus, hipDeviceAttributeMultiprocessorCount, dev);
    hipFuncSetAttribute((const void*)fwd_megakernel, hipFuncAttributeMaxDynamicSharedMemorySize, (int)kDynLds);
    hipOccupancyMaxActiveBlocksPerMultiprocessor(&per_cu, fwd_megakernel, NTHR, kDynLds);
    if (per_cu < 1) per_cu = 1;
    grid_blocks = cus * per_cu;
    if (grid_blocks > MAXGRID) grid_blocks = MAXGRID;
    if (B_END > ws_size) fprintf(stderr, "workspace too small: need %zu have %zu\n", (size_t)B_END, ws_size);
  }
  Params p{};
  for (int i = 0; i < 28; ++i) p.in[i] = (const float*)d_in[i];
  p.out = (float*)d_out;
  p.ws = (char*)d_ws;
  (void)hipMemsetAsync((char*)d_ws + B_BAR, 0, BAR_BYTES, stream);
  void* args[] = {&p};
  hipError_t e = hipLaunchCooperativeKernel((void*)fwd_megakernel, dim3(grid_blocks), dim3(NTHR), args, kDynLds, stream);
  if (e != hipSuccess) fprintf(stderr, "cooperative launch failed: %s (grid %d)\n", hipGetErrorString(e), grid_blocks);
}
```

```cpp
#include <hip/hip_runtime.h>
#include <hip/hip_bf16.h>
#include <hip/hip_cooperative_groups.h>
#include <cstdio>
namespace cg = cooperative_groups;

typedef unsigned short u16;
using bf16x8 = __attribute__((ext_vector_type(8))) short;
using f32x4 = __attribute__((ext_vector_type(4))) float;
using f32x16 = __attribute__((ext_vector_type(16))) float;
typedef __bf16 bf16x2_t __attribute__((ext_vector_type(2)));
typedef float f32x2_t __attribute__((ext_vector_type(2)));
#define DI __device__ __forceinline__

constexpr int T_ = 32768, S_ = 16384, DM = 1024, DFF = 2816, NL = 4;
constexpr int UW = 4096;
constexpr int UQ = 0, UK = 512, UV = 640, USC = 768, UQLAT = 2304, UKVLAT = 2688, ULRU = 2944, UKROPE = 3968;
constexpr int NTHR = 512;
constexpr int MAXGRID = 256;

constexpr size_t O_WI1 = 0;
constexpr size_t O_WO1 = O_WI1 + (size_t)5632 * 1024;
constexpr size_t O_WIN = O_WO1 + (size_t)1024 * 2816;
constexpr size_t O_WQUP = O_WIN + (size_t)8192 * 1024;
constexpr size_t O_WKVUP = O_WQUP + (size_t)768 * 384;
constexpr size_t O_WBR = O_WKVUP + (size_t)1024 * 256;
constexpr size_t O_WOUT = O_WBR + (size_t)4 * 1024 * 512;
constexpr size_t O_WI2 = O_WOUT + (size_t)1024 * 1024;
constexpr size_t O_WO2 = O_WI2 + (size_t)5632 * 1024;
constexpr size_t W_ELEMS = O_WO2 + (size_t)1024 * 2816;

constexpr size_t AL(size_t x) { return (x + 255) & ~(size_t)255; }
constexpr size_t B_WB = 0;
constexpr size_t B_H = AL(B_WB + W_ELEMS * 2);
constexpr size_t B_U = AL(B_H + (size_t)T_ * 1024 * 2);
constexpr size_t B_R = AL(B_U + (size_t)T_ * UW * 2);
constexpr size_t B_QM = B_R;
constexpr size_t B_KVM = AL(B_QM + (size_t)T_ * 768 * 2);
constexpr size_t B_VTM = AL(B_KVM + (size_t)T_ * 1024 * 2);
constexpr size_t B_VTG = AL(B_VTM + (size_t)T_ * 512 * 2);
constexpr size_t B_MERGED = B_R;
constexpr size_t B_SCR = AL(B_MERGED + (size_t)T_ * 1024 * 2);
constexpr size_t SCR_PER_BLOCK = (size_t)NTHR * 192 * 4;
constexpr size_t B_REND1 = AL(B_VTG + (size_t)T_ * 128 * 2);
constexpr size_t B_REND2 = AL(B_SCR + SCR_PER_BLOCK * MAXGRID);
constexpr size_t B_SMALL = (B_REND1 > B_REND2 ? B_REND1 : B_REND2);
constexpr size_t B_TABG_R = B_SMALL;
constexpr size_t B_TABG_C = AL(B_TABG_R + 256 * 16 * 8);
constexpr size_t B_TABM_R = AL(B_TABG_C + 64 * 16 * 8);
constexpr size_t B_TABM_C = AL(B_TABM_R + 256 * 8 * 8);
constexpr size_t B_SUMM = AL(B_TABM_C + 64 * 8 * 8);
constexpr size_t B_CARRY = AL(B_SUMM + (size_t)2 * 2 * 256 * 512 * 8);
constexpr size_t B_BAR = AL(B_CARRY + (size_t)2 * 2 * 256 * 512 * 4);
constexpr size_t BAR_BYTES = 3456 * 4;
constexpr size_t B_END = AL(B_BAR + BAR_BYTES);

struct Params {
  const float* in[28];
  float* out;
  char* ws;
};

typedef const __attribute__((address_space(4))) Params CParams;

DI u16 f2bf(float x) { unsigned u = __float_as_uint(x); u += 0x7fffu + ((u >> 16) & 1u); return (u16)(u >> 16); }
DI float bf2f(u16 b) { return __uint_as_float(((unsigned)b) << 16); }
DI unsigned pack2(float a, float b) { f32x2_t v = {a, b}; bf16x2_t r = __builtin_convertvector(v, bf16x2_t); return __builtin_bit_cast(unsigned, r); }
DI float lo2f(unsigned p) { return __uint_as_float(p << 16); }
DI float hi2f(unsigned p) { return __uint_as_float(p & 0xffff0000u); }
DI float shx(float v, int o, int lane) { return __int_as_float(__builtin_amdgcn_ds_bpermute((lane ^ o) << 2, __float_as_int(v))); }
DI float wave_sum(float v, int lane) {
#pragma unroll
  for (int o = 32; o >= 1; o >>= 1) v += shx(v, o, lane);
  return v;
}
typedef unsigned v2u_t __attribute__((ext_vector_type(2)));
DI float wsum_dpp(float v) {
  v += __int_as_float(__builtin_amdgcn_update_dpp(0, __float_as_int(v), 0xB1, 0xF, 0xF, true));
  v += __int_as_float(__builtin_amdgcn_update_dpp(0, __float_as_int(v), 0x4E, 0xF, 0xF, true));
  v += __int_as_float(__builtin_amdgcn_update_dpp(0, __float_as_int(v), 0x141, 0xF, 0xF, true));
  v += __int_as_float(__builtin_amdgcn_update_dpp(0, __float_as_int(v), 0x140, 0xF, 0xF, true));
  v2u_t a = __builtin_amdgcn_permlane16_swap(__float_as_uint(v), __float_as_uint(v), false, false);
  v = __uint_as_float(a[0]) + __uint_as_float(a[1]);
  v2u_t b = __builtin_amdgcn_permlane32_swap(__float_as_uint(v), __float_as_uint(v), false, false);
  return __uint_as_float(b[0]) + __uint_as_float(b[1]);
}
DI float xor16_(float y, int lane) {
  v2u_t a = __builtin_amdgcn_permlane16_swap(__float_as_uint(y), __float_as_uint(y), false, false);
  return (lane & 16) ? __uint_as_float(a[0]) : __uint_as_float(a[1]);
}
DI float xor4_(float y) {
  float t = __int_as_float(__builtin_amdgcn_update_dpp(0, __float_as_int(y), 0x141, 0xF, 0xF, true));
  return __int_as_float(__builtin_amdgcn_update_dpp(0, __float_as_int(t), 0x1B, 0xF, 0xF, true));
}
DI float rcp_(float x) { return __builtin_amdgcn_rcpf(x); }
DI float sigmoidf_(float x) { return rcp_(1.f + __expf(-x)); }
DI float softplus_neg(float lm) {
  float e = __expf(-lm);
  return (e < 0.03f) ? e * (1.f - e * (0.5f - e * (1.f / 3.f - 0.25f * e))) : __logf(1.f + e);
}
DI float one_minus_exp(float z) {
  return (z > -0.25f) ? -z * (1.f + z * (0.5f + z * (1.f / 6.f + z * (1.f / 24.f + z * (1.f / 120.f))))) : 1.f - __expf(z);
}
DI float tanh_(float y) { return 1.f - 2.f * rcp_(1.f + __expf(2.f * y)); }
DI int tid_() { int t = threadIdx.x; asm volatile("" : "+v"(t)); return t; }
DI int permkey(int k) { return (k & ~12) | ((k & 4) << 1) | ((k & 8) >> 1); }

constexpr int BM = 256, BK = 64, HALF = 128, HT = HALF * BK;
DI int lds_byte(int r, int c) {
  int st = (r >> 4) * 2 + (c >> 5), rr = r & 15, cc = c & 31, ob = rr * 64 + cc * 2;
  return st * 1024 + (ob ^ (((ob >> 9) & 1) << 5));
}
DI void stage_rc(int b, int& R, int& C) {
  int st = b / 1024, sb = b % 1024, swz = sb ^ (((sb >> 9) & 1) << 5);
  R = (st >> 1) * 16 + swz / 64; C = (st & 1) * 32 + (swz % 64) / 2;
}

typedef f32x4 acc_t[4][4];
constexpr int BN = 128;

template <bool LOWREG = false, class Epi>
DI void gemm_tile(const u16* __restrict__ A, int lda, const u16* __restrict__ Bt, int ldb, int K, int brow, int bcol, Epi epi,
               bool preloaded = false, bool hasNext = false, int nbrow = 0, int nbcol = 0) {
  const int tid = tid_();
  extern __shared__ __attribute__((aligned(16))) char smem[];
  u16* shm = (u16*)smem;
#define SA(b, h) (shm + ((b) * 3 + (h)) * HT)
#define SB(b) (shm + ((b) * 3 + 2) * HT)
#define STAGE(P, BASE, LD, br, kt, O0, O1) do { const u16* _gb = (BASE) + (size_t)(br) * (LD) + (size_t)(kt) * BK; \
    __builtin_amdgcn_global_load_lds((const unsigned*)(_gb + (O0)), (__attribute__((address_space(3))) unsigned*)((char*)(P) + tid * 16), 16, 0, 0); \
    __builtin_amdgcn_global_load_lds((const unsigned*)(_gb + (O1)), (__attribute__((address_space(3))) unsigned*)((char*)(P) + tid * 16 + 8192), 16, 0, 0); } while (0)
#define STAGEA(P, br, kt) STAGE(P, A, lda, br, kt, oA0, oA1)
#define STAGEB(P, br, kt) STAGE(P, Bt, ldb, br, kt, oB0, oB1)
#define STAGE_ALL(bufi, kt) do { STAGEA(SA(bufi, 0), brow, kt); STAGEA(SA(bufi, 1), brow + HALF, kt); STAGEB(SB(bufi), bcol, kt); } while (0)
#define STAGE_NEXT(bufi, kt) do { STAGEA(SA(bufi, 0), nbrow, kt); STAGEA(SA(bufi, 1), nbrow + HALF, kt); STAGEB(SB(bufi), nbcol, kt); } while (0)
#define WAIT_V(n) asm volatile("s_waitcnt vmcnt(" #n ")" ::: "memory")
#define BAR __builtin_amdgcn_s_barrier()

  if (!preloaded) {
    asm volatile("s_waitcnt vmcnt(0)" ::: "memory");
    __syncthreads();
  }
  const int wid = tid >> 6, lane = tid & 63, wr = wid >> 1, wc = wid & 1, fr = lane & 15, fq = lane >> 4;
  acc_t acc;
#pragma unroll
  for (int m = 0; m < 4; ++m)
#pragma unroll
    for (int n = 0; n < 4; ++n) acc[m][n] = f32x4{0.f, 0.f, 0.f, 0.f};
  const int nt = K / BK;
  unsigned oA0, oA1, oB0, oB1;
  { int _r, _c; stage_rc(tid * 16, _r, _c); oA0 = _r * lda + _c; oB0 = _r * ldb + _c;
    stage_rc(tid * 16 + 8192, _r, _c); oA1 = _r * lda + _c; oB1 = _r * ldb + _c; }
  if (!preloaded) {
    STAGE_ALL(0, 0);
    if (nt > 1) STAGE_ALL(1, 1);
  }
  int b = 0;
  if (LOWREG) {
#pragma unroll 1
    for (int t = 0; t < nt; ++t) {
      if (t + 1 < nt) WAIT_V(6); else WAIT_V(0);
      BAR;
      if (t + 2 < nt) { const int b2 = (b == 0) ? 2 : b - 1; STAGE_ALL(b2, t + 2); }
      const char* pa = (const char*)SA(b, wr >> 1);
      const char* pb = (const char*)SB(b);
#pragma unroll
      for (int k = 0; k < 2; ++k) {
        bf16x8 At[4], Bf[4];
#pragma unroll
        for (int m = 0; m < 4; ++m) At[m] = *reinterpret_cast<const bf16x8*>(pa + lds_byte((wr & 1) * 64 + m * 16 + fr, k * 32 + fq * 8));
#pragma unroll
        for (int n = 0; n < 4; ++n) Bf[n] = *reinterpret_cast<const bf16x8*>(pb + lds_byte(wc * 64 + n * 16 + fr, k * 32 + fq * 8));
#pragma unroll
        for (int m = 0; m < 4; ++m)
#pragma unroll
          for (int n = 0; n < 4; ++n) acc[m][n] = __builtin_amdgcn_mfma_f32_16x16x32_bf16(Bf[n], At[m], acc[m][n], 0, 0, 0);
        __builtin_amdgcn_sched_barrier(0);
      }
      b = (b == 2) ? 0 : b + 1;
    }
  } else {
    const int grp = wid >> 2;
    if (nt > 1 && !preloaded) WAIT_V(6); else WAIT_V(0);
    __syncthreads();
    if (grp == 1) BAR;
#pragma unroll 1
    for (int t = 0; t < nt; ++t) {
      const char* pa = (const char*)SA(b, wr >> 1);
      const char* pb = (const char*)SB(b);
      bf16x8 At[4][2], Bf[4][2];
#pragma unroll
      for (int m = 0; m < 4; ++m)
#pragma unroll
        for (int k = 0; k < 2; ++k) At[m][k] = *reinterpret_cast<const bf16x8*>(pa + lds_byte((wr & 1) * 64 + m * 16 + fr, k * 32 + fq * 8));
#pragma unroll
      for (int n = 0; n < 4; ++n)
#pragma unroll
        for (int k = 0; k < 2; ++k) Bf[n][k] = *reinterpret_cast<const bf16x8*>(pb + lds_byte(wc * 64 + n * 16 + fr, k * 32 + fq * 8));
      if (t + 2 < nt) { const int b2 = (b == 0) ? 2 : b - 1; STAGE_ALL(b2, t + 2); WAIT_V(6); } else { WAIT_V(0); }
      asm volatile("s_waitcnt lgkmcnt(0)" ::: "memory");
      __builtin_amdgcn_sched_barrier(0);
      BAR;
      __builtin_amdgcn_sched_barrier(0);
      __builtin_amdgcn_s_setprio(1);
#pragma unroll
      for (int k = 0; k < 2; ++k)
#pragma unroll
        for (int m = 0; m < 4; ++m)
#pragma unroll
          for (int n = 0; n < 4; ++n) acc[m][n] = __builtin_amdgcn_mfma_f32_16x16x32_bf16(Bf[n][k], At[m][k], acc[m][n], 0, 0, 0);
      __builtin_amdgcn_s_setprio(0);
      __builtin_amdgcn_sched_barrier(0);
      BAR;
      __builtin_amdgcn_sched_barrier(0);
      b = (b == 2) ? 0 : b + 1;
    }
    if (hasNext) {
      STAGE_NEXT(0, 0);
      if (nt > 1) STAGE_NEXT(1, 1);
    }
    epi(acc, brow, bcol);
    if (grp == 0) BAR;
  }
  if (LOWREG) epi(acc, brow, bcol);
#undef SA
#undef SB
}

#define EPI_IDS const int tid = tid_(); const int wid = tid >> 6, lane = tid & 63, wr = wid >> 1, wc = wid & 1, fr = lane & 15, fq = lane >> 4; (void)wr; (void)wc; (void)fr; (void)fq;

struct EpiStoreBf16 {
  u16* out; int ld;
  DI void operator()(acc_t& acc, int brow, int bcol) const {
    EPI_IDS
#pragma unroll
    for (int m = 0; m < 4; ++m)
#pragma unroll
      for (int n = 0; n < 4; ++n) {
        int row = brow + wr * 64 + m * 16 + fr, col = bcol + wc * 64 + n * 16 + fq * 4;
        uint2 v = {pack2(acc[m][n][0], acc[m][n][1]), pack2(acc[m][n][2], acc[m][n][3])};
        *(uint2*)(out + (unsigned)(row * ld + col)) = v;
      }
  }
};
struct EpiSwiglu {
  u16* out;
  DI void operator()(acc_t& acc, int brow, int bcol) const {
    EPI_IDS
    const int cb = (bcol >> 7) * 64 + wc * 32;
#pragma unroll
    for (int m = 0; m < 4; ++m)
#pragma unroll
      for (int n = 0; n < 2; ++n) {
        int row = brow + wr * 64 + m * 16 + fr, col = cb + n * 16 + fq * 4;
        float r[4];
#pragma unroll
        for (int j = 0; j < 4; ++j) { float g = acc[m][n][j], u = acc[m][n + 2][j]; r[j] = g * sigmoidf_(g) * u; }
        uint2 v = {pack2(r[0], r[1]), pack2(r[2], r[3])};
        *(uint2*)(out + (unsigned)(row * DFF + col)) = v;
      }
  }
};
struct EpiResid {
  float* x; float c;
  DI void operator()(acc_t& acc, int brow, int bcol) const {
    EPI_IDS
    f32x4 v[16];
#pragma unroll
    for (int m = 0; m < 4; ++m)
#pragma unroll
      for (int n = 0; n < 4; ++n) {
        const int row = brow + wr * 64 + m * 16 + fr, col = bcol + wc * 64 + n * 16 + fq * 4;
        v[m * 4 + n] = *(const f32x4*)(x + (unsigned)(row * DM + col));
      }
    asm volatile("" : "+v"(v[0]), "+v"(v[1]), "+v"(v[2]), "+v"(v[3]), "+v"(v[4]), "+v"(v[5]), "+v"(v[6]), "+v"(v[7]));
    asm volatile("" : "+v"(v[8]), "+v"(v[9]), "+v"(v[10]), "+v"(v[11]), "+v"(v[12]), "+v"(v[13]), "+v"(v[14]), "+v"(v[15]));
#pragma unroll
    for (int m = 0; m < 4; ++m)
#pragma unroll
      for (int n = 0; n < 4; ++n) {
        const int row = brow + wr * 64 + m * 16 + fr, col = bcol + wc * 64 + n * 16 + fq * 4;
        f32x4 w = v[m * 4 + n];
        w[0] += c * acc[m][n][0]; w[1] += c * acc[m][n][1]; w[2] += c * acc[m][n][2]; w[3] += c * acc[m][n][3];
        *(f32x4*)(x + (unsigned)(row * DM + col)) = w;
      }
  }
};
struct EpiGateReg {
  unsigned* gp;
  DI void operator()(acc_t& acc, int brow, int bcol) const {
    int e = 0;
#pragma unroll
    for (int m = 0; m < 4; ++m)
#pragma unroll
      for (int n = 0; n < 4; ++n)
#pragma unroll
        for (int j = 0; j < 4; j += 2) { gp[e] = pack2(sigmoidf_(acc[m][n][j]), sigmoidf_(acc[m][n][j + 1])); ++e; }
  }
};
struct EpiMergeReg {
  const unsigned* gp; unsigned* macc;
  DI void operator()(acc_t& acc, int brow, int bcol) const {
    int e = 0;
#pragma unroll
    for (int m = 0; m < 4; ++m)
#pragma unroll
      for (int n = 0; n < 4; ++n)
#pragma unroll
        for (int j = 0; j < 4; j += 2) {
          macc[e] = pack2(lo2f(macc[e]) + lo2f(gp[e]) * acc[m][n][j], hi2f(macc[e]) + hi2f(gp[e]) * acc[m][n][j + 1]);
          ++e;
        }
  }
};

DI void tile_map(int tile, int nM, int nN, int& pm, int& pn) {
  const int WGM = 8;
  int nig = WGM * nN, gid = tile / nig, fm = gid * WGM, gsz = min(nM - fm, WGM);
  pm = fm + ((tile % nig) % gsz); pn = (tile % nig) / gsz;
}

DI int map_col(int mode, int np) {
  if (mode == 0) return np;
  if (mode == 1) { int tile = np >> 7, wc = (np >> 6) & 1, half = (np >> 5) & 1, c = np & 31; return half * DFF + tile * 64 + wc * 32 + c; }
  if (np < 2944) return np;
  if (np < 3968) return np + 32;
  if (np < 4000) return np - 1024;
  if (np < 4096) return -1;
  return np - 96;
}
DI void conv_tile(const float* __restrict__ src, u16* __restrict__ dst, int K, int Nsrc, int mode, int tile) {
  const int tid = tid_();
  extern __shared__ __attribute__((aligned(16))) char smem[];
  float* ts = (float*)smem;
  const int nkt = K / 128;
  const int nt_ = tile / nkt, kt = tile % nkt;
  const int n0 = nt_ * 32, k0 = kt * 128;
  const int ns = map_col(mode, n0);
  __syncthreads();
  {
    int n = tid & 31, k = tid >> 5;
    float v[8];
#pragma unroll
    for (int p = 0; p < 8; ++p) v[p] = (ns >= 0) ? src[(size_t)(k0 + k + 16 * p) * Nsrc + ns + n] : 0.f;
#pragma unroll
    for (int p = 0; p < 8; ++p) ts[(k + 16 * p) * 33 + n] = v[p];
  }
  __syncthreads();
  {
    int n = tid >> 4, kc = (tid & 15) * 8;
    uint4 v;
    v.x = pack2(ts[(kc + 0) * 33 + n], ts[(kc + 1) * 33 + n]);
    v.y = pack2(ts[(kc + 2) * 33 + n], ts[(kc + 3) * 33 + n]);
    v.z = pack2(ts[(kc + 4) * 33 + n], ts[(kc + 5) * 33 + n]);
    v.w = pack2(ts[(kc + 6) * 33 + n], ts[(kc + 7) * 33 + n]);
    *(uint4*)(dst + (size_t)(n0 + n) * K + k0 + kc) = v;
  }
}
DI void phase_convert(CParams& p, int layer) {
  u16* wb = (u16*)(p.ws + B_WB);
  for (int item = blockIdx.x;; item += gridDim.x) {
    int t = item;
    const float* src; u16* dst; int K, Nsrc, Ndst, mode;
#define JOB(SRC, DST, K_, NSRC_, NDST_, MODE_) { int cnt = ((NDST_) / 32) * ((K_) / 128); if (t < cnt) { src = (SRC); dst = (DST); K = (K_); Nsrc = (NSRC_); Ndst = (NDST_); mode = (MODE_); goto found; } t -= cnt; }
    JOB(p.in[2] + (size_t)layer * 1024 * 5632, wb + O_WI1, 1024, 5632, 5632, 1)
    JOB(p.in[3] + (size_t)layer * 2816 * 1024, wb + O_WO1, 2816, 1024, 1024, 0)
    JOB(p.in[5] + (size_t)layer * 1024 * 8096, wb + O_WIN, 1024, 8096, 8192, 2)
    JOB(p.in[11] + (size_t)layer * 384 * 768, wb + O_WQUP, 384, 768, 768, 0)
    JOB(p.in[13] + (size_t)layer * 256 * 1024, wb + O_WKVUP, 256, 1024, 1024, 0)
    JOB(p.in[23] + (size_t)(layer * 4 + 0) * 512 * 1024, wb + O_WBR + (size_t)0 * 1024 * 512, 512, 1024, 1024, 0)
    JOB(p.in[23] + (size_t)(layer * 4 + 1) * 512 * 1024, wb + O_WBR + (size_t)1 * 1024 * 512, 512, 1024, 1024, 0)
    JOB(p.in[23] + (size_t)(layer * 4 + 2) * 512 * 1024, wb + O_WBR + (size_t)2 * 1024 * 512, 512, 1024, 1024, 0)
    JOB(p.in[23] + (size_t)(layer * 4 + 3) * 512 * 1024, wb + O_WBR + (size_t)3 * 1024 * 512, 512, 1024, 1024, 0)
    JOB(p.in[24] + (size_t)layer * 1024 * 1024, wb + O_WOUT, 1024, 1024, 1024, 0)
    JOB(p.in[26] + (size_t)layer * 1024 * 5632, wb + O_WI2, 1024, 5632, 5632, 1)
    JOB(p.in[27] + (size_t)layer * 2816 * 1024, wb + O_WO2, 2816, 1024, 1024, 0)
#undef JOB
    break;
  found:
    (void)Ndst;
    conv_tile(src, dst, K, Nsrc, mode, t);
  }
}

DI void phase_tables(CParams& p) {
  const int tid = tid_();
  float2* gr = (float2*)(p.ws + B_TABG_R); float2* gc = (float2*)(p.ws + B_TABG_C);
  float2* mr = (float2*)(p.ws + B_TABM_R); float2* mc = (float2*)(p.ws + B_TABM_C);
  int gt = blockIdx.x * NTHR + tid, gs = gridDim.x * NTHR;
  for (int i = gt; i < 256 * 16; i += gs) { int pos = i >> 4, f = i & 15; float inv = __builtin_amdgcn_exp2f(-(float)(2 * f) / 32.f * 13.287712379549449f); float a = (float)pos * inv; gr[i] = make_float2(__cosf(a), __sinf(a)); }
  for (int i = gt; i < 64 * 16; i += gs) { int pos = i >> 4, f = i & 15; float inv = __builtin_amdgcn_exp2f(-(float)(2 * f) / 32.f * 13.287712379549449f); float a = (float)pos * inv; gc[i] = make_float2(__cosf(a), __sinf(a)); }
  for (int i = gt; i < 256 * 8; i += gs) { int pos = i >> 3, f = i & 7; float inv = __builtin_amdgcn_exp2f(-(float)(2 * f) / 16.f * 13.287712379549449f); float a = (float)pos * inv; mr[i] = make_float2(__cosf(a), __sinf(a)); }
  for (int i = gt; i < 64 * 8; i += gs) { int pos = i >> 3, f = i & 7; float inv = __builtin_amdgcn_exp2f(-(float)(2 * f) / 16.f * 13.287712379549449f); float a = (float)pos * inv; mc[i] = make_float2(__cosf(a), __sinf(a)); }
}

DI void phase_norm(const float* __restrict__ xsrc, float* __restrict__ xcopy, const float* __restrict__ g, u16* __restrict__ h) {
  const int tid = tid_();
  const int wid = tid >> 6, lane = tid & 63;
  for (int row = blockIdx.x * 8 + wid; row < T_; row += gridDim.x * 8) {
    const float4* xr = (const float4*)(xsrc + (size_t)row * DM);
    float4 v[4]; float ss = 0.f;
#pragma unroll
    for (int i = 0; i < 4; ++i) { v[i] = xr[lane + 64 * i]; ss += v[i].x * v[i].x + v[i].y * v[i].y + v[i].z * v[i].z + v[i].w * v[i].w; }
    ss = wsum_dpp(ss);
    float rs = rsqrtf(ss * (1.f / DM) + 1e-6f);
#pragma unroll
    for (int i = 0; i < 4; ++i) {
      float4 gg = ((const float4*)g)[lane + 64 * i];
      uint2 o = {pack2(v[i].x * rs * gg.x, v[i].y * rs * gg.y), pack2(v[i].z * rs * gg.z, v[i].w * rs * gg.w)};
      *(uint2*)(h + (size_t)row * DM + (lane + 64 * i) * 4) = o;
      if (xcopy) ((float4*)(xcopy + (size_t)row * DM))[lane + 64 * i] = v[i];
    }
  }
}

DI bool tile_map_xcd(int bid, int nblk, int round, int nM, int nN, int& pm, int& pn) {
  if (nblk != 256 || nM != 128 || (nN & 3)) return false;
  const int xcd = bid & 7, loc = bid >> 3, lr = loc & 7, lc = loc >> 3;
  const int ncg = nN >> 2;
  const int cg = round % ncg, rg = round / ncg;
  pm = xcd + 8 * (rg * 8 + lr); pn = cg * 4 + lc;
  return true;
}
template <class Epi>
DI void gemm_phase(const u16* A, int lda, const u16* Bt, int ldb, int K, int M, int N, Epi epi, int first, int stride) {
  const int nM = M / BM, nN = N / BN, ntile = nM * nN;
  int round = 0, pm = 0, pn = 0;
  if (first < ntile) { if (!tile_map_xcd(first, stride, 0, nM, nN, pm, pn)) tile_map(first, nM, nN, pm, pn); }
  for (int tile = first; tile < ntile; tile += stride, ++round) {
    const int nxt = tile + stride;
    const bool hasNext = nxt < ntile;
    int qm = 0, qn = 0;
    if (hasNext) { if (!tile_map_xcd(first, stride, round + 1, nM, nN, qm, qn)) tile_map(nxt, nM, nN, qm, qn); }
    gemm_tile(A, lda, Bt, ldb, K, pm * BM, pn * BN, epi, round > 0, hasNext, qm * BM, qn * BN);
    pm = qm; pn = qn;
  }
}

struct PostTok { u16 rh[10], rq[6], rk[4]; uint4 bg, cg[3], xs[3]; float2 cs; };
DI void post_load(const u16* __restrict__ u, int t, int s, int lane, const float2* tgr, const float2* tgc, PostTok& d) {
  const u16* ur = u + (size_t)t * UW;
  const int rowp = s >> 6, colp = s & 63;
  d.cs = (lane < 32) ? tgr[rowp * 16 + (lane & 15)] : tgc[colp * 16 + (lane & 15)];
#pragma unroll
  for (int hd = 0; hd < 10; ++hd) d.rh[hd] = ur[hd * 64 + lane];
#pragma unroll
  for (int k = 0; k < 6; ++k) d.rq[k] = ur[UQLAT + lane + 64 * k];
#pragma unroll
  for (int k = 0; k < 4; ++k) d.rk[k] = ur[UKVLAT + lane + 64 * k];
  const int c0 = lane * 8;
  d.bg = *(const uint4*)(ur + USC + c0);
#pragma unroll
  for (int k = 0; k < 3; ++k) {
    const int s2 = s + k - 1;
    if (s2 >= 0 && s2 < S_) {
      const u16* r2 = u + (size_t)(t + k - 1) * UW + USC;
      d.cg[k] = *(const uint4*)(r2 + 512 + c0); d.xs[k] = *(const uint4*)(r2 + 1024 + c0);
    } else { d.cg[k] = uint4{0, 0, 0, 0}; d.xs[k] = uint4{0, 0, 0, 0}; }
  }
}
DI void post_tile(CParams& p, int layer, int tile) {
  const int tid = tid_();
  extern __shared__ __attribute__((aligned(16))) char smem[];
  u16* u = (u16*)(p.ws + B_U);
  const float2* tgr = (const float2*)(p.ws + B_TABG_R); const float2* tgc = (const float2*)(p.ws + B_TABG_C);
  const int wid = tid >> 6, lane = tid & 63;
  const int tb = tile * 64;
  const int b = tb / S_, sb = tb % S_;
  const float* qn = p.in[6] + layer * 64; const float* kn = p.in[7] + layer * 64;
  const float* scw = p.in[8] + layer * 3 * 512; const float* scb = p.in[9] + layer * 512;
  const float* qan = p.in[10] + layer * 384; const float* kvan = p.in[12] + layer * 256;
  const float gq = qn[lane], gk = kn[lane];
  float qanr[6], kvanr[4], scwr[3][8], scbr[8];
#pragma unroll
  for (int k = 0; k < 6; ++k) qanr[k] = qan[lane + 64 * k];
#pragma unroll
  for (int k = 0; k < 4; ++k) kvanr[k] = kvan[lane + 64 * k];
#pragma unroll
  for (int e = 0; e < 8; ++e) { scbr[e] = scb[lane * 8 + e];
#pragma unroll
    for (int k = 0; k < 3; ++k) scwr[k][e] = scw[k * 512 + lane * 8 + e]; }
  __syncthreads();
  PostTok dA, dB;
  post_load(u, tb + wid * 8, sb + wid * 8, lane, tgr, tgc, dA);
#pragma unroll
  for (int i = 0; i < 8; ++i) {
    PostTok& d = (i & 1) ? dB : dA;
    PostTok& dn = (i & 1) ? dA : dB;
    const int tl = wid * 8 + i, t = tb + tl, s = sb + tl;
    if (i + 1 < 8) post_load(u, t + 1, s + 1, lane, tgr, tgc, dn);
    u16* ur = u + (size_t)t * UW;
    const float2 cs = d.cs;
    float xh[10], ss[12];
#pragma unroll
    for (int hd = 0; hd < 10; ++hd) { xh[hd] = bf2f(d.rh[hd]); ss[hd] = xh[hd] * xh[hd]; }
    float xq[6], xk[4];
    ss[10] = 0.f; ss[11] = 0.f;
#pragma unroll
    for (int k = 0; k < 6; ++k) { xq[k] = bf2f(d.rq[k]); ss[10] += xq[k] * xq[k]; }
#pragma unroll
    for (int k = 0; k < 4; ++k) { xk[k] = bf2f(d.rk[k]); ss[11] += xk[k] * xk[k]; }
#pragma unroll
    for (int c = 0; c < 12; ++c) ss[c] = wsum_dpp(ss[c]);
    float yh[10], prh[10];
#pragma unroll
    for (int hd = 0; hd < 10; ++hd) yh[hd] = xh[hd] * rsqrtf(ss[hd] * (1.f / 64.f) + 1e-6f) * (hd < 8 ? gq : gk);
#pragma unroll
    for (int hd = 0; hd < 10; ++hd) prh[hd] = xor16_(yh[hd], lane);
#pragma unroll
    for (int hd = 0; hd < 10; ++hd) {
      float o = yh[hd] * cs.x + ((lane & 16) ? prh[hd] : -prh[hd]) * cs.y;
      if (hd < 8) o *= 0.125f * 1.4426950408889634f;
      ur[hd * 64 + lane] = f2bf(o);
    }
    {
      float rs = rsqrtf(ss[10] * (1.f / 384.f) + 1e-6f);
#pragma unroll
      for (int k = 0; k < 6; ++k) ur[UQLAT + lane + 64 * k] = f2bf(xq[k] * rs * qanr[k]);
      float rs2 = rsqrtf(ss[11] * (1.f / 256.f) + 1e-6f);
#pragma unroll
      for (int k = 0; k < 4; ++k) ur[UKVLAT + lane + 64 * k] = f2bf(xk[k] * rs2 * kvanr[k]);
    }
    {
      const int c0 = lane * 8;
      float accv[8];
#pragma unroll
      for (int e = 0; e < 8; ++e) accv[e] = scbr[e];
#pragma unroll
      for (int k = 0; k < 3; ++k) {
        const unsigned cgs[4] = {d.cg[k].x, d.cg[k].y, d.cg[k].z, d.cg[k].w}; const unsigned xss[4] = {d.xs[k].x, d.xs[k].y, d.xs[k].z, d.xs[k].w};
#pragma unroll
        for (int e = 0; e < 4; ++e) {
          accv[2 * e] += scwr[k][2 * e] * (lo2f(cgs[e]) * lo2f(xss[e]));
          accv[2 * e + 1] += scwr[k][2 * e + 1] * (hi2f(cgs[e]) * hi2f(xss[e]));
        }
      }
      const uint4 bg = d.bg;
      uint4 o;
      o.x = pack2(lo2f(bg.x) * accv[0], hi2f(bg.x) * accv[1]);
      o.y = pack2(lo2f(bg.y) * accv[2], hi2f(bg.y) * accv[3]);
      o.z = pack2(lo2f(bg.z) * accv[4], hi2f(bg.z) * accv[5]);
      o.w = pack2(lo2f(bg.w) * accv[6], hi2f(bg.w) * accv[7]);
      *(uint4*)(ur + USC + c0) = o;
    }
  }
  {
    u16* ls = (u16*)smem;
    int tok = tid >> 3, ch = tid & 7;
    const u16* src = u + (size_t)(tb + tok) * UW + UV + ch * 16;
    uint4 a = *(const uint4*)src, c = *(const uint4*)(src + 8);
    const unsigned w[8] = {a.x, a.y, a.z, a.w, c.x, c.y, c.z, c.w};
    int pt = permkey(tok);
#pragma unroll
    for (int e = 0; e < 8; ++e) {
      ls[(ch * 16 + 2 * e) * 72 + pt] = (u16)(w[e] & 0xffff);
      ls[(ch * 16 + 2 * e + 1) * 72 + pt] = (u16)(w[e] >> 16);
    }
    __syncthreads();
    u16* vtg = (u16*)(p.ws + B_VTG);
#pragma unroll
    for (int k = 0; k < 2; ++k) {
      int idx = tid + 512 * k, row = idx >> 3, c8 = idx & 7;
      uint4 v = *(const uint4*)(ls + row * 72 + c8 * 8);
      *(uint4*)(vtg + ((size_t)(b * 2 + (row >> 6)) * 64 + (row & 63)) * S_ + sb + c8 * 8) = v;
    }
  }
}

DI void lru_phase(CParams& p, int layer, int pass, int bid, int nblk, unsigned* qctr = nullptr, volatile unsigned __attribute__((address_space(3)))* qslot = nullptr) {
  const int tid = tid_();
  extern __shared__ __attribute__((aligned(16))) char smem[];
  u16* xcb = (u16*)smem;
  float* xcf = (float*)(smem + 64 * 72 * 2);
  float* G = xcf + 64 * 64;
  float2* part = (float2*)(G + 4 * 64 * 64);
  u16* u = (u16*)(p.ws + B_U);
  const float* cw = p.in[16] + layer * 4 * 512; const float* cb = p.in[17] + layer * 512;
  const float* lam = p.in[22] + (size_t)layer * 2 * 512;
  const int wid = tid >> 6, lane = tid & 63;
  const int mi = wid >> 1, dh = wid & 1, r = lane & 31, hh = lane >> 5, mdir = mi >> 1;
  const int ctok = tid >> 3, ccg = (tid & 7) * 8;
  const int ec = tid & 63;
  const int sdir = tid >> 8, ssub = (tid >> 6) & 3;
  int nbPrev = -1;
  bf16x8 wf[4]; float bs = 0.f, sp0 = 0.f, sp1 = 0.f;
  float cwr[4][8], cbr[8];
  const int qcls = (bid >> 3) & 7;
#pragma unroll 1
  for (int item = bid;; item += nblk) {
    if (qctr) {
      if (tid == 0) *qslot = atomicAdd(qctr + qcls, 1u);
      __syncthreads();
      const unsigned tk = *qslot;
      if (tk >= 512u) break;
      item = (int)tk * 8 + qcls;
    } else if (item >= 4096) break;
    const int nb = item & 7, j = (item >> 3) & 255, b = item >> 11;
    const int c0 = nb * 64, s0 = j * 64;
    if (nb != nbPrev) {
      nbPrev = nb;
      const float* W = ((mi & 1) ? p.in[20] : p.in[18]) + ((size_t)((layer * 2 + mdir) * 8 + nb)) * 64 * 64;
      const float* bias = ((mi & 1) ? p.in[21] : p.in[19]) + (size_t)(layer * 2 + mdir) * 512 + c0;
#pragma unroll
      for (int ks = 0; ks < 4; ++ks) {
        unsigned bw[4];
#pragma unroll
        for (int jj = 0; jj < 4; ++jj) {
          float w0 = W[(16 * ks + 8 * hh + 2 * jj) * 64 + 32 * dh + r];
          float w1 = W[(16 * ks + 8 * hh + 2 * jj + 1) * 64 + 32 * dh + r];
          bw[jj] = pack2(w0, w1);
        }
        uint4 bq = {bw[0], bw[1], bw[2], bw[3]};
        wf[ks] = __builtin_bit_cast(bf16x8, bq);
      }
      bs = bias[32 * dh + r];
      sp0 = softplus_neg(lam[c0 + ec]); sp1 = softplus_neg(lam[512 + c0 + ec]);
#pragma unroll
      for (int e = 0; e < 8; ++e) {
        cbr[e] = cb[c0 + ccg + e];
#pragma unroll
        for (int k = 0; k < 4; ++k) cwr[k][e] = cw[k * 512 + c0 + ccg + e];
      }
    }
    __syncthreads();
    {
      float a[8];
#pragma unroll
      for (int e = 0; e < 8; ++e) a[e] = cbr[e];
#pragma unroll
      for (int k = 0; k < 4; ++k) {
        int s2 = s0 + ctok + k - 2;
        if (s2 >= 0 && s2 < S_) {
          uint4 xv = *(const uint4*)(u + (size_t)(b * S_ + s2) * UW + ULRU + 512 + c0 + ccg);
          const unsigned w[4] = {xv.x, xv.y, xv.z, xv.w};
#pragma unroll
          for (int e = 0; e < 4; ++e) {
            a[2 * e] += cwr[k][2 * e] * lo2f(w[e]);
            a[2 * e + 1] += cwr[k][2 * e + 1] * hi2f(w[e]);
          }
        }
      }
#pragma unroll
      for (int e = 0; e < 8; ++e) xcf[ctok * 64 + ccg + e] = a[e];
      uint4 o = {pack2(a[0], a[1]), pack2(a[2], a[3]), pack2(a[4], a[5]), pack2(a[6], a[7])};
      *(uint4*)(xcb + ctok * 72 + ccg) = o;
    }
    u16* gp = u + (size_t)(b * S_ + s0 + ctok) * UW + ULRU + c0 + ccg;
    uint4 gv = {0, 0, 0, 0};
    if (pass == 3) gv = *(const uint4*)gp;
    __syncthreads();
    {
      f32x16 acc0, acc1;
#pragma unroll
      for (int i = 0; i < 16; ++i) { acc0[i] = 0.f; acc1[i] = 0.f; }
#pragma unroll
      for (int ks = 0; ks < 4; ++ks) {
        bf16x8 a0 = *(const bf16x8*)(xcb + (r)*72 + 16 * ks + 8 * hh);
        bf16x8 a1 = *(const bf16x8*)(xcb + (32 + r) * 72 + 16 * ks + 8 * hh);
        acc0 = __builtin_amdgcn_mfma_f32_32x32x16_bf16(a0, wf[ks], acc0, 0, 0, 0);
        acc1 = __builtin_amdgcn_mfma_f32_32x32x16_bf16(a1, wf[ks], acc1, 0, 0, 0);
      }
#pragma unroll
      for (int i = 0; i < 16; ++i) {
        int row = (i & 3) + 8 * (i >> 2) + 4 * hh;
        G[(mi * 64 + row) * 64 + 32 * dh + r] = sigmoidf_(acc0[i] + bs);
        G[(mi * 64 + 32 + row) * 64 + 32 * dh + r] = sigmoidf_(acc1[i] + bs);
      }
    }
    __syncthreads();
    {
      const float* Ga = G + (2 * sdir) * 4096; float* Gb = G + (2 * sdir + 1) * 4096;
      const int tb = ssub * 16;
      const float sp = sdir ? sp1 : sp0;
      float av[16], bv[16];
#pragma unroll
      for (int k = 0; k < 16; ++k) {
        const int t = tb + (sdir ? 15 - k : k);
        const float rr = Ga[t * 64 + ec], ii = Gb[t * 64 + ec];
        const float la = -8.f * rr * sp;
        av[k] = __expf(la);
        bv[k] = __builtin_amdgcn_sqrtf(fmaxf(1.f - av[k] * av[k], 0.f)) * ii * xcf[t * 64 + ec];
      }
      float hv = 0.f, P = 1.f;
#pragma unroll
      for (int k = 0; k < 16; ++k) { hv = av[k] * hv + bv[k]; P *= av[k]; }
      part[(sdir * 4 + ssub) * 64 + ec] = make_float2(P, hv);
      __syncthreads();
      const size_t sidx = ((size_t)((b * 2 + sdir) * 256 + j)) * 512 + c0 + ec;
      if (pass == 1) {
        if (ssub == 0) {
          float Pt = 1.f, ht = 0.f;
#pragma unroll
          for (int q = 0; q < 4; ++q) { float2 pq = part[(sdir * 4 + (sdir ? 3 - q : q)) * 64 + ec]; ht = pq.x * ht + pq.y; Pt *= pq.x; }
          ((float2*)(p.ws + B_SUMM))[sidx] = make_float2(Pt, ht);
        }
      } else {
        float cin = ((const float*)(p.ws + B_CARRY))[sidx];
#pragma unroll
        for (int q = 0; q < 3; ++q) {
          const int sq = sdir ? 3 - q : q;
          const bool before = sdir ? (sq > ssub) : (sq < ssub);
          float2 pq = part[(sdir * 4 + sq) * 64 + ec];
          if (before) cin = pq.x * cin + pq.y;
        }
        hv = cin;
#pragma unroll
        for (int k = 0; k < 16; ++k) { const int t = tb + (sdir ? 15 - k : k); hv = av[k] * hv + bv[k]; Gb[t * 64 + ec] = hv; }
      }
    }
    if (pass == 3) {
      __syncthreads();
      const unsigned w[4] = {gv.x, gv.y, gv.z, gv.w};
      float o[8];
#pragma unroll
      for (int e = 0; e < 8; ++e) {
        float g = (e & 1) ? hi2f(w[e >> 1]) : lo2f(w[e >> 1]);
        float ge = 0.5f * g * (1.f + tanh_(0.7978845608028654f * (g + 0.044715f * g * g * g)));
        o[e] = ge * (G[(1 * 64 + ctok) * 64 + ccg + e] + G[(3 * 64 + ctok) * 64 + ccg + e]);
      }
      uint4 ov = {pack2(o[0], o[1]), pack2(o[2], o[3]), pack2(o[4], o[5]), pack2(o[6], o[7])};
      *(uint4*)gp = ov;
    }
  }
}
DI void lru_carry(CParams& p, int blk) {
  const int tid = tid_();
  int id = blk * NTHR + tid;
  int c = id & 511, dir = (id >> 9) & 1, b = id >> 10;
  const float2* __restrict__ sm = (const float2*)(p.ws + B_SUMM) + (size_t)(b * 2 + dir) * 256 * 512 + c;
  float* __restrict__ cr = (float*)(p.ws + B_CARRY) + (size_t)(b * 2 + dir) * 256 * 512 + c;
  float cin = 0.f;
#pragma unroll 1
  for (int k0 = 0; k0 < 256; k0 += 32) {
    float2 ab[32];
#pragma unroll
    for (int i = 0; i < 32; ++i) { const int j = dir ? 255 - (k0 + i) : (k0 + i); ab[i] = sm[(size_t)j * 512]; }
#pragma unroll
    for (int i = 0; i < 32; ++i) {
      const int j = dir ? 255 - (k0 + i) : (k0 + i);
      cr[(size_t)j * 512] = cin;
      cin = ab[i].x * cin + ab[i].y;
    }
  }
}

template <int D>
DI void attn_tile(const u16* __restrict__ Qp, int ldq, const u16* __restrict__ Kp, int ldk, const u16* __restrict__ Vt,
                  u16* __restrict__ Op, int ldo, int q0, float cs, float mc) {
  const int tid = tid_();
  extern __shared__ __attribute__((aligned(16))) char smem[];
  constexpr int KS = D * 2 + 16, VS = 144, KB = 64 * KS, VB = 64 * VS, BUF = KB + VB;
  constexpr int NKS = D / 16, CPR = D / 8;
  constexpr int NIT = S_ / 64;
  const int wid = tid >> 6, lane = tid & 63, r = lane & 31, hh = lane >> 5, grp = wid >> 2;
  __syncthreads();
  bf16x8 qf[NKS];
  {
    const u16* qr = Qp + (size_t)(q0 + wid * 32 + r) * ldq + 8 * hh;
#pragma unroll
    for (int ks = 0; ks < NKS; ++ks) qf[ks] = *(const bf16x8*)(qr + 16 * ks);
  }
  f32x16 o0, o1, s0, s1;
#pragma unroll
  for (int i = 0; i < 16; ++i) { o0[i] = 0.f; o1[i] = 0.f; }
  float lsum0 = 0.f, lsum1 = 0.f;
  uint4 kr0, kr1, vr;
  const int vrow = tid >> 3, vch = tid & 7;
  int krow0, kch0, krow1 = 0, kch1 = 0;
  if (D == 64) { krow0 = tid >> 3; kch0 = tid & 7; }
  else { krow0 = tid / CPR; kch0 = tid % CPR; int i2 = tid + 512; krow1 = i2 / CPR; kch1 = i2 % CPR; }
  const bool k2 = (D == 96) && (tid < 256);
  kr1 = uint4{0, 0, 0, 0};
#define LOADT(key0) do { kr0 = *(const uint4*)(Kp + (size_t)((key0) + krow0) * ldk + kch0 * 8); \
    if (k2) kr1 = *(const uint4*)(Kp + (size_t)((key0) + krow1) * ldk + kch1 * 8); \
    vr = *(const uint4*)(Vt + (size_t)vrow * S_ + (key0) + vch * 8); } while (0)
#define STORET(bufi) do { char* bb = smem + (bufi) * BUF; *(uint4*)(bb + krow0 * KS + kch0 * 16) = kr0; \
    if (k2) *(uint4*)(bb + krow1 * KS + kch1 * 16) = kr1; \
    *(uint4*)(bb + KB + vrow * VS + vch * 16) = vr; } while (0)
#define LOADKF(bufi) do { const char* kb_ = smem + (bufi) * BUF + r * KS + 16 * hh; \
    _Pragma("unroll") for (int ks = 0; ks < NKS; ++ks) { kf0[ks] = *(const bf16x8*)(kb_ + 32 * ks); kf1[ks] = *(const bf16x8*)(kb_ + 32 * KS + 32 * ks); } } while (0)
#define SMMA() do { const f32x16 z_ = {0.f, 0.f, 0.f, 0.f, 0.f, 0.f, 0.f, 0.f, 0.f, 0.f, 0.f, 0.f, 0.f, 0.f, 0.f, 0.f}; \
    s0 = __builtin_amdgcn_mfma_f32_32x32x16_bf16(kf0[0], qf[0], z_, 0, 0, 0); \
    s1 = __builtin_amdgcn_mfma_f32_32x32x16_bf16(kf1[0], qf[0], z_, 0, 0, 0); \
    _Pragma("unroll") for (int ks = 1; ks < NKS; ++ks) { s0 = __builtin_amdgcn_mfma_f32_32x32x16_bf16(kf0[ks], qf[ks], s0, 0, 0, 0); \
      s1 = __builtin_amdgcn_mfma_f32_32x32x16_bf16(kf1[ks], qf[ks], s1, 0, 0, 0); } } while (0)
#define BARX do { __builtin_amdgcn_sched_barrier(0); asm volatile("s_waitcnt lgkmcnt(0)" ::: "memory"); __builtin_amdgcn_s_barrier(); __builtin_amdgcn_sched_barrier(0); } while (0)
  bf16x8 kf0[NKS], kf1[NKS];
  LOADT(0); STORET(0);
  LOADT(64); STORET(1);
  __syncthreads();
  LOADT(128);
  LOADKF(0);
  SMMA();
  if (grp == 1) BARX;
#pragma unroll 1
  for (int it = 0; it < NIT; ++it) {
    bf16x8 pf[2][2];
    if (mc != 0.f) {
#pragma unroll
      for (int i = 0; i < 16; ++i) { s0[i] -= mc; s1[i] -= mc; }
    }
#pragma unroll
    for (int i = 0; i < 16; ++i) {
      s0[i] = __builtin_amdgcn_exp2f(s0[i]); s1[i] = __builtin_amdgcn_exp2f(s1[i]);
      lsum0 += s0[i]; lsum1 += s1[i];
    }
#pragma unroll
    for (int st = 0; st < 2; ++st) {
      uint4 a = {pack2(s0[8 * st], s0[8 * st + 1]), pack2(s0[8 * st + 2], s0[8 * st + 3]), pack2(s0[8 * st + 4], s0[8 * st + 5]), pack2(s0[8 * st + 6], s0[8 * st + 7])};
      uint4 c = {pack2(s1[8 * st], s1[8 * st + 1]), pack2(s1[8 * st + 2], s1[8 * st + 3]), pack2(s1[8 * st + 4], s1[8 * st + 5]), pack2(s1[8 * st + 6], s1[8 * st + 7])};
      pf[0][st] = __builtin_bit_cast(bf16x8, a); pf[1][st] = __builtin_bit_cast(bf16x8, c);
    }
    if (it + 2 < NIT) STORET((it + 2) & 3);
    if (it + 3 < NIT) LOADT((it + 3) * 64);
    if (it + 1 < NIT) LOADKF((it + 1) & 3);
    BARX;
    __builtin_amdgcn_s_setprio(1);
    {
      const char* vb = smem + (it & 3) * BUF + KB + r * VS + 16 * hh;
      bf16x8 v0[2], v1[2];
#pragma unroll
      for (int q = 0; q < 2; ++q) { v0[q] = *(const bf16x8*)(vb + 32 * q); v1[q] = *(const bf16x8*)(vb + 32 * VS + 32 * q); }
      if (it + 1 < NIT) SMMA();
#pragma unroll
      for (int q = 0; q < 2; ++q) {
        o0 = __builtin_amdgcn_mfma_f32_32x32x16_bf16(v0[q], pf[0][q], o0, 0, 0, 0);
        o1 = __builtin_amdgcn_mfma_f32_32x32x16_bf16(v1[q], pf[0][q], o1, 0, 0, 0);
      }
#pragma unroll
      for (int q = 0; q < 2; ++q) { v0[q] = *(const bf16x8*)(vb + 64 + 32 * q); v1[q] = *(const bf16x8*)(vb + 32 * VS + 64 + 32 * q); }
#pragma unroll
      for (int q = 0; q < 2; ++q) {
        o0 = __builtin_amdgcn_mfma_f32_32x32x16_bf16(v0[q], pf[1][q], o0, 0, 0, 0);
        o1 = __builtin_amdgcn_mfma_f32_32x32x16_bf16(v1[q], pf[1][q], o1, 0, 0, 0);
      }
    }
    __builtin_amdgcn_s_setprio(0);
    BARX;
  }
#undef LOADT
#undef STORET
#undef LOADKF
#undef SMMA
  float lsum = lsum0 + lsum1;
  lsum += shx(lsum, 32, lane);
  const float inv = rcp_(lsum);
  u16* orow = Op + (size_t)(q0 + wid * 32 + r) * ldo;
#pragma unroll
  for (int g = 0; g < 4; ++g) {
    uint2 a = {pack2(o0[4 * g] * inv, o0[4 * g + 1] * inv), pack2(o0[4 * g + 2] * inv, o0[4 * g + 3] * inv)};
    uint2 c = {pack2(o1[4 * g] * inv, o1[4 * g + 1] * inv), pack2(o1[4 * g + 2] * inv, o1[4 * g + 3] * inv)};
    *(uint2*)(orow + 8 * g + 4 * hh) = a;
    *(uint2*)(orow + 32 + 8 * g + 4 * hh) = c;
  }
  if (grp == 0) BARX;
#undef BARX
}

DI float gain_absmax(const float* g, int n) {
  float m = 0.f;
  for (int i = 0; i < n; ++i) m = fmaxf(m, fabsf(g[i]));
  return m;
}

struct MlaTok { unsigned qw[8], kw[8]; float2 c0, c1; };
DI void mla_load(const u16* __restrict__ u, const u16* __restrict__ qm, const u16* __restrict__ kvm, int t, int s, int lane, int e0, bool rl,
                 const float2* tmr, const float2* tmc, MlaTok& d) {
  const int rowp = s >> 6, colp = s & 63;
  d.c0 = float2{1.f, 0.f}; d.c1 = float2{1.f, 0.f};
  if (rl) {
    if (e0 < 16) { d.c0 = tmr[rowp * 8 + (e0 & 7)]; d.c1 = tmr[rowp * 8 + ((e0 + 1) & 7)]; }
    else { d.c0 = tmc[colp * 8 + (e0 & 7)]; d.c1 = tmc[colp * 8 + ((e0 + 1) & 7)]; }
  }
  const unsigned kro = rl ? *(const unsigned*)(u + (size_t)t * UW + UKROPE + e0) : 0u;
#pragma unroll
  for (int hd = 0; hd < 8; ++hd) {
    d.qw[hd] = (lane < 48) ? *(const unsigned*)(qm + (size_t)t * 768 + hd * 96 + 2 * lane) : 0u;
    d.kw[hd] = (lane < 32) ? *(const unsigned*)(kvm + (size_t)t * 1024 + hd * 128 + 2 * lane) : kro;
  }
}
DI void mla_post_tile(CParams& p, int layer, int tile) {
  const int tid = tid_();
  extern __shared__ __attribute__((aligned(16))) char smem[];
  u16* ls = (u16*)smem;
  u16* u = (u16*)(p.ws + B_U); u16* qm = (u16*)(p.ws + B_QM); u16* kvm = (u16*)(p.ws + B_KVM); u16* vtm = (u16*)(p.ws + B_VTM);
  const float2* tmr = (const float2*)(p.ws + B_TABM_R); const float2* tmc = (const float2*)(p.ws + B_TABM_C);
  const float* qn = p.in[14] + layer * 96; const float* kn = p.in[15] + layer * 96;
  const int wid = tid >> 6, lane = tid & 63;
  const int tb = tile * 64, b = tb / S_, sb = tb % S_;
  __syncthreads();
#pragma unroll
  for (int k = 0; k < 8; ++k) {
    int idx = tid + 512 * k, tok = idx >> 6, cc = idx & 63, hd = cc >> 3, dvc = (cc & 7) * 8;
    uint4 v = *(const uint4*)(kvm + (size_t)(tb + tok) * 1024 + hd * 128 + 64 + dvc);
    const unsigned w[4] = {v.x, v.y, v.z, v.w};
    int pt = permkey(tok);
#pragma unroll
    for (int e = 0; e < 4; ++e) {
      ls[(hd * 64 + dvc + 2 * e) * 72 + pt] = (u16)(w[e] & 0xffff);
      ls[(hd * 64 + dvc + 2 * e + 1) * 72 + pt] = (u16)(w[e] >> 16);
    }
  }
  __syncthreads();
  const int e0 = 2 * (lane - 32);
  const bool rl = lane >= 32 && lane < 48;
  float gq0 = 0.f, gq1 = 0.f, gk0 = 0.f, gk1 = 0.f;
  if (lane < 48) { gq0 = qn[2 * lane]; gq1 = qn[2 * lane + 1]; gk0 = kn[2 * lane]; gk1 = kn[2 * lane + 1]; }
  MlaTok mA, mB;
  mla_load(u, qm, kvm, tb + wid * 8, sb + wid * 8, lane, e0, rl, tmr, tmc, mA);
#pragma unroll
  for (int i = 0; i < 8; ++i) {
    MlaTok& d = (i & 1) ? mB : mA;
    MlaTok& dn = (i & 1) ? mA : mB;
    const int tl = wid * 8 + i, t = tb + tl;
    if (i + 1 < 8) mla_load(u, qm, kvm, t + 1, sb + tl + 1, lane, e0, rl, tmr, tmc, dn);
    const float2 c0 = d.c0, c1 = d.c1;
    float ss[16];
#pragma unroll
    for (int hd = 0; hd < 8; ++hd) {
      float a0 = lo2f(d.qw[hd]), a1 = hi2f(d.qw[hd]), b0 = lo2f(d.kw[hd]), b1 = hi2f(d.kw[hd]);
      ss[hd] = a0 * a0 + a1 * a1; ss[8 + hd] = b0 * b0 + b1 * b1;
    }
#pragma unroll
    for (int c = 0; c < 16; ++c) ss[c] = wsum_dpp(ss[c]);
    const float qsc = (1.f / 9.797958971132712f) * 1.4426950408889634f;
    const bool up = (e0 & 8) != 0;
#pragma unroll
    for (int hd = 0; hd < 8; ++hd) {
      {
        float rs = rsqrtf(ss[hd] * (1.f / 96.f) + 1e-6f);
        float y0 = lo2f(d.qw[hd]) * rs * gq0, y1 = hi2f(d.qw[hd]) * rs * gq1;
        float p0 = xor4_(y0), p1 = xor4_(y1);
        if (rl) { y0 = y0 * c0.x + (up ? p0 : -p0) * c0.y; y1 = y1 * c1.x + (up ? p1 : -p1) * c1.y; }
        if (lane < 48) *(unsigned*)(qm + (size_t)t * 768 + hd * 96 + 2 * lane) = pack2(y0 * qsc, y1 * qsc);
      }
      {
        float rs = rsqrtf(ss[8 + hd] * (1.f / 96.f) + 1e-6f);
        float y0 = lo2f(d.kw[hd]) * rs * gk0, y1 = hi2f(d.kw[hd]) * rs * gk1;
        float p0 = xor4_(y0), p1 = xor4_(y1);
        if (rl) { y0 = y0 * c0.x + (up ? p0 : -p0) * c0.y; y1 = y1 * c1.x + (up ? p1 : -p1) * c1.y; }
        if (lane < 48) *(unsigned*)(kvm + (size_t)t * 1024 + hd * 128 + 2 * lane) = pack2(y0, y1);
      }
    }
  }
#pragma unroll
  for (int k = 0; k < 8; ++k) {
    int idx = tid + 512 * k, row = idx >> 3, c8 = idx & 7;
    uint4 v = *(const uint4*)(ls + row * 72 + c8 * 8);
    *(uint4*)(vtm + ((size_t)(b * 8 + (row >> 6)) * 64 + (row & 63)) * S_ + sb + c8 * 8) = v;
  }
}


#define XB_TMO      128
#define XB_XCNT(j)  (256  + 64 * (j))
#define XB_XSUB(j)  (1280 + 64 * (j))
#define XB_XGEN(j)  (2304 + 64 * (j))
#define XB_TOP      3328
#define XB_TOPGEN   3392
#define XB_SPIN_CAP (1u << 24)
#define LAS __attribute__((address_space(3)))
DI unsigned xb_ld(unsigned* p) { return __hip_atomic_load(p, __ATOMIC_RELAXED, __HIP_MEMORY_SCOPE_AGENT); }
DI unsigned xb_add(unsigned* p, unsigned v) { return __hip_atomic_fetch_add(p, v, __ATOMIC_RELAXED, __HIP_MEMORY_SCOPE_AGENT); }
DI unsigned xb_xcc_id() { return (unsigned)__builtin_amdgcn_s_getreg((3 << 11) | 20) & 0xFu; }
#define XB_SPIN(cond, bar) do { unsigned _sp = 0; while (cond) { __builtin_amdgcn_s_sleep(1); \
    if ((++_sp & 255u) == 0u) { if (xb_ld(&(bar)[XB_TMO])) break; if (_sp > XB_SPIN_CAP) { atomicAdd(&(bar)[XB_TMO], 1u); break; } } } } while (0)
struct XcdBarrier { unsigned* bar; unsigned x; volatile LAS unsigned* st; };
DI XcdBarrier xcd_barrier_post(unsigned* bar, volatile LAS unsigned* st) {
  XcdBarrier b; b.bar = bar; b.x = xb_xcc_id(); b.st = st;
  if (threadIdx.x == 0) (void)xb_add(&bar[XB_XCNT(b.x)], 1u);
  return b;
}
DI void xcd_barrier_complete(unsigned* bar, unsigned x, unsigned& nloc, unsigned& nx) {
  const unsigned G = gridDim.x * gridDim.y * gridDim.z;
  unsigned sum, cnt, mine, sp = 0u;
  for (;;) {
    sum = 0u; cnt = 0u; mine = 0u;
#pragma unroll
    for (unsigned j = 0; j < 16; ++j) { const unsigned c = xb_ld(&bar[XB_XCNT(j)]); sum += c; cnt += (c > 0u) ? 1u : 0u; mine = (j == x) ? c : mine; }
    if (sum == G) break;
    __builtin_amdgcn_s_sleep(1);
    if ((++sp & 255u) == 0u) { if (xb_ld(&bar[XB_TMO])) break; if (sp > XB_SPIN_CAP) { atomicAdd(&bar[XB_TMO], 1u); break; } }
  }
  nloc = mine > 0u ? mine : 1u; nx = cnt > 0u ? cnt : 1u;
}
DI void xcd_barrier(const XcdBarrier& b) {
  asm volatile("s_waitcnt vmcnt(0)" ::: "memory");
  __syncthreads();
  if (threadIdx.x == 0) {
    unsigned* bar = b.bar;
    __builtin_amdgcn_s_waitcnt(0);
    unsigned nloc = b.st[0], nx = b.st[1];
    if (nloc == 0u) { xcd_barrier_complete(bar, b.x, nloc, nx); b.st[0] = nloc; b.st[1] = nx; }
    const unsigned old = xb_add(&bar[XB_XSUB(b.x)], 1u);
    const unsigned gen = old / nloc;
    if (old + 1u == (gen + 1u) * nloc) {
      __builtin_amdgcn_fence(__ATOMIC_RELEASE, "agent");
      asm volatile("s_waitcnt vmcnt(0)" ::: "memory");
      const unsigned og = xb_add(&bar[XB_TOP], 1u);
      const unsigned tg = og / nx;
      if (og + 1u == (tg + 1u) * nx) xb_add(&bar[XB_TOPGEN], 1u);
      else XB_SPIN(xb_ld(&bar[XB_TOPGEN]) == tg, bar);
      __builtin_amdgcn_fence(__ATOMIC_ACQUIRE, "agent");
      xb_add(&bar[XB_XGEN(b.x)], 1u);
      asm volatile("s_waitcnt vmcnt(0)" ::: "memory");
    } else {
      XB_SPIN(xb_ld(&bar[XB_XGEN(b.x)]) == gen, bar);
      __builtin_amdgcn_fence(__ATOMIC_ACQUIRE, "agent");
      asm volatile("s_waitcnt vmcnt(0)" ::: "memory");
    }
  }
  __syncthreads();
}

__global__ void __launch_bounds__(NTHR) fwd_megakernel(Params p_unused) {
  cg::grid_group grid = cg::this_grid();
  __shared__ uint4 xb_words;
  if (threadIdx.x == 0) xb_words = make_uint4(0u, 0u, 0u, 0u);
  __syncthreads();
  XcdBarrier xb = xcd_barrier_post((unsigned*)(((CParams*)__builtin_amdgcn_kernarg_segment_ptr())->ws + B_BAR), (volatile LAS unsigned*)&xb_words);
  if (gridDim.x == 0x7fffffffu) grid.sync();
  const float LOG2E = 1.4426950408889634f;
  constexpr int NPH = 14;
#pragma unroll 1
  for (int step = 0; step < NL * NPH; ++step) {
    int layer = step / NPH; const int ph = step % NPH;
    asm volatile("" : "+s"(layer));
    int bid = blockIdx.x, nblk = gridDim.x;
    asm volatile("" : "+s"(bid)); asm volatile("" : "+s"(nblk));
    CParams* pp = (CParams*)__builtin_amdgcn_kernarg_segment_ptr();
    asm volatile("" : "+s"(pp));
    CParams& p = *pp;
    u16* wb = (u16*)(p.ws + B_WB);
    u16* h = (u16*)(p.ws + B_H);
    u16* u = (u16*)(p.ws + B_U);
    float* x = p.out;
    switch (ph) {
      case 0: {
        if (layer == 0) phase_tables(p);
        phase_convert(p, layer);
        phase_norm(layer == 0 ? p.in[0] : x, layer == 0 ? x : nullptr, p.in[1] + layer * DM, h);
      } break;
      case 1: gemm_phase(h, DM, wb + O_WI1, DM, DM, T_, 2 * DFF, EpiSwiglu{u}, bid, nblk); break;
      case 2: gemm_phase(u, DFF, wb + O_WO1, DFF, DFF, T_, DM, EpiResid{x, 0.5f}, bid, nblk); break;
      case 3: phase_norm(x, nullptr, p.in[4] + layer * DM, h); break;
      case 4: gemm_phase(h, DM, wb + O_WIN, DM, DM, T_, UW, EpiStoreBf16{u, UW}, bid, nblk); break;
      case 5: {
        for (int it = bid; it < 512; it += nblk) post_tile(p, layer, it);
        lru_phase(p, layer, 1, bid, nblk);
      } break;
      case 6: {
        u16* qm = (u16*)(p.ws + B_QM); u16* kvm = (u16*)(p.ws + B_KVM); u16* vtg = (u16*)(p.ws + B_VTG);
        if (bid < 4) lru_carry(p, bid);
        float mcg = 8.f * gain_absmax(p.in[6] + layer * 64, 64) * gain_absmax(p.in[7] + layer * 64, 64) * LOG2E;
        if (mcg < 60.f) mcg = 0.f;
        const float csg = 0.125f * LOG2E;
        for (int it = bid; it < 1024; it += nblk) {
          int g = it & 3, qt = (it >> 2) & 63, kvh = (it >> 8) & 1, b = it >> 9;
          int hq = kvh * 4 + g;
          attn_tile<64>(u + (size_t)b * S_ * UW + UQ + hq * 64, UW, u + (size_t)b * S_ * UW + UK + kvh * 64, UW,
                        vtg + (size_t)(b * 2 + kvh) * 64 * S_, u + (size_t)b * S_ * UW + UQ + hq * 64, UW, qt * 256, csg, mcg);
        }
        {
          unsigned* qc = (unsigned*)(p.ws + B_BAR) + 1 + layer * 9 + 8;
          volatile LAS unsigned* qslot = (volatile LAS unsigned*)&xb_words.z;
          for (;;) {
            if (threadIdx.x == 0) *qslot = atomicAdd(qc, 1u);
            __syncthreads();
            const int tk = (int)*qslot;
            if (tk >= 768 + 1024) break;
            if (tk < 768) {
              int pm, pn; tile_map(tk, 128, 6, pm, pn);
              gemm_tile(u + UQLAT, UW, wb + O_WQUP, 384, 384, pm * BM, pn * BN, EpiStoreBf16{qm, 768});
            } else {
              int pm, pn; tile_map(tk - 768, 128, 8, pm, pn);
              gemm_tile(u + UKVLAT, UW, wb + O_WKVUP, 256, 256, pm * BM, pn * BN, EpiStoreBf16{kvm, 1024});
            }
          }
        }
      } break;
      case 7: {
        for (int it = bid; it < 512; it += nblk) mla_post_tile(p, layer, it);
      } break;
      case 8: {
        u16* qm = (u16*)(p.ws + B_QM); u16* kvm = (u16*)(p.ws + B_KVM); u16* vtm = (u16*)(p.ws + B_VTM);
        const float sq96 = 9.797958971132712f;
        float mcm = sq96 * gain_absmax(p.in[14] + layer * 96, 96) * gain_absmax(p.in[15] + layer * 96, 96) * LOG2E;
        if (mcm < 60.f) mcm = 0.f;
        const float csm = (1.f / sq96) * LOG2E;
        for (int it = bid; it < 1024; it += nblk) {
          int qt = it & 63, hd = (it >> 6) & 7, b = it >> 9;
          attn_tile<96>(qm + (size_t)b * S_ * 768 + hd * 96, 768, kvm + (size_t)b * S_ * 1024 + hd * 128, 1024,
                        vtm + (size_t)(b * 8 + hd) * 64 * S_, u + (size_t)b * S_ * UW + UQLAT + hd * 64, UW, qt * 256, csm, mcm);
        }
        lru_phase(p, layer, 3, bid, nblk, (unsigned*)(p.ws + B_BAR) + 1 + layer * 9, (volatile LAS unsigned*)&xb_words.z);
      } break;
      case 9: {
        u16* merged = (u16*)(p.ws + B_MERGED);
        int round9 = 0;
        for (int tile = bid; tile < 128 * 8; tile += nblk, ++round9) {
          int pm, pn;
          if (!tile_map_xcd(bid, nblk, round9, 128, 8, pm, pn)) tile_map(tile, 128, 8, pm, pn);
          unsigned macc[32];
#pragma unroll
          for (int e = 0; e < 32; ++e) macc[e] = 0u;
#pragma unroll 1
          for (int n = 0; n < 4; ++n) {
            const int brc = (n == 0) ? UQ : (n == 1) ? USC : (n == 2) ? UQLAT : ULRU;
            unsigned gp[32];
            gemm_tile<false>(h, DM, wb + O_WIN + (size_t)(4096 + n * 1024) * DM, DM, DM, pm * BM, pn * BN, EpiGateReg{gp});
            gemm_tile<false>(u + brc, UW, wb + O_WBR + (size_t)n * 1024 * 512, 512, 512, pm * BM, pn * BN, EpiMergeReg{gp, macc});
          }
          {
            const int tid = tid_();
            const int wid = tid >> 6, lane = tid & 63, wr = wid >> 1, wc = wid & 1, fr = lane & 15, fq = lane >> 4;
#pragma unroll
            for (int m = 0; m < 4; ++m)
#pragma unroll
              for (int n = 0; n < 4; ++n) {
                const int e = (m * 4 + n) * 2;
                int row = pm * BM + wr * 64 + m * 16 + fr, col = pn * BN + wc * 64 + n * 16 + fq * 4;
                uint2 v = {macc[e], macc[e + 1]};
                *(uint2*)(merged + (unsigned)(row * DM + col)) = v;
              }
          }
        }
      } break;
      case 10: gemm_phase((u16*)(p.ws + B_MERGED), DM, wb + O_WOUT, DM, DM, T_, DM, EpiResid{x, 1.0f}, bid, nblk); break;
      case 11: phase_norm(x, nullptr, p.in[25] + layer * DM, h); break;
      case 12: gemm_phase(h, DM, wb + O_WI2, DM, DM, T_, 2 * DFF, EpiSwiglu{u}, bid, nblk); break;
      case 13: gemm_phase(u, DFF, wb + O_WO2, DFF, DFF, T_, DM, EpiResid{x, 0.5f}, bid, nblk); break;
    }
    if (step + 1 < NL * NPH) xcd_barrier(xb);
  }
}

constexpr size_t kDynLds = 147456;

extern "C" void kernel_launch(void* const* d_in, const int* in_sizes, int n_in, void* d_out, int out_size, void* d_ws, size_t ws_size,
                              hipStream_t stream) {
  static int grid_blocks = 0;
  if (!grid_blocks) {
    int dev = 0, cus = 0, per_cu = 0;
    hipGetDevice(&dev);
    hipDeviceGetAttribute(&cus, hipDeviceAttributeMultiprocessorCount, dev);
    hipFuncSetAttribute((const void*)fwd_megakernel, hipFuncAttributeMaxDynamicSharedMemorySize, (int)kDynLds);
    hipOccupancyMaxActiveBlocksPerMultiprocessor(&per_cu, fwd_megakernel, NTHR, kDynLds);
    if (per_cu < 1) per_cu = 1;
    grid_blocks = cus * per_cu;
    if (grid_blocks > MAXGRID) grid_blocks = MAXGRID;
    if (B_END > ws_size) fprintf(stderr, "workspace too small: need %zu have %zu\n", (size_t)B_END, ws_size);
  }
  Params p{};
  for (int i = 0; i < 28; ++i) p.in[i] = (const float*)d_in[i];
  p.out = (float*)d_out;
  p.ws = (char*)d_ws;
  (void)hipMemsetAsync((char*)d_ws + B_BAR, 0, BAR_BYTES, stream);
  void* args[] = {&p};
  hipError_t e = hipLaunchCooperativeKernel((void*)fwd_megakernel, dim3(grid_blocks), dim3(NTHR), args, kDynLds, stream);
  if (e != hipSuccess) fprintf(stderr, "cooperative launch failed: %s (grid %d)\n", hipGetErrorString(e), grid_blocks);
}
```
